# Optimizing an MI355X kernel written in HIP

```python
import jax, jax.numpy as jnp
from jax import lax
import numpy as np


D_MODEL = 1024
BATCH = 4
SEQ = 8192
DEPTH = 2

N_SUB = 3
HALF_STEP = 0.5
D_FF = 2816
CONV_WIDTH = 4
EPS = 1e-6
LRU_WIDTH = D_MODEL
LRU_HEADS = 8
LRU_BLOCK = LRU_WIDTH // LRU_HEADS
LRU_C = 8.0
SSD_WIDTH = D_MODEL
SSD_HEADDIM = 64
SSD_HEADS = SSD_WIDTH // SSD_HEADDIM
SSD_GROUPS = 2
SSD_STATE = 128
SSD_CHUNK = 128
SSD_CONV_DIM = SSD_WIDTH + 2 * SSD_GROUPS * SSD_STATE
HYB_SPLITS = (LRU_WIDTH, 2 * LRU_WIDTH, 2 * LRU_WIDTH + SSD_WIDTH, 2 * LRU_WIDTH + SSD_WIDTH + SSD_CONV_DIM)
HYB_IN = HYB_SPLITS[-1] + SSD_HEADS
HYB_OUT = LRU_WIDTH + SSD_WIDTH
MLSTM_WIDTH = 2 * D_MODEL
MLSTM_HEADS = 4
MLSTM_HEADDIM = MLSTM_WIDTH // MLSTM_HEADS
MLSTM_QKV_BLOCK = 4
MLSTM_CHUNK = 64
N_EVEN = (DEPTH + 1) // 2
N_ODD = DEPTH // 2

kernel_name = 'hybrid_rglru_ssd_mlstm_macaron_adaln'


def rms_norm(x, g):
    xf = x.astype(jnp.float32)
    y = xf * lax.rsqrt(jnp.mean(xf * xf, axis=-1, keepdims=True) + EPS)
    return (y * g.astype(jnp.float32)).astype(x.dtype)


def head_layer_norm(h, g):
    mu = jnp.mean(h, axis=-1, keepdims=True)
    hc = h - mu
    var = jnp.mean(hc * hc, axis=-1, keepdims=True)
    return hc * lax.rsqrt(var + EPS) * g.astype(jnp.float32)


def causal_conv(x, w, b):
    width, ch = w.shape
    y = lax.conv_general_dilated(x, w[:, None, :].astype(x.dtype), window_strides=(1,),
                                 padding=((width - 1, 0),), dimension_numbers=('NWC', 'WIO', 'NWC'),
                                 feature_group_count=ch)
    return y + b


def block_diag_linear(x, w):
    nb, bi, bo = w.shape
    xb = x.reshape(x.shape[:-1] + (nb, bi))
    return jnp.einsum('...ni,nio->...no', xb, w).reshape(x.shape[:-1] + (nb * bo,))


def swiglu(h, w_gate, w_up, w_down):
    return (jax.nn.silu(h @ w_gate) * (h @ w_up)) @ w_down


def rg_lru(x, w_a, b_a, w_x, b_x, lam):
    xf = x.astype(jnp.float32)
    r = jax.nn.sigmoid(block_diag_linear(xf, w_a.astype(jnp.float32)) + b_a.astype(jnp.float32))
    i = jax.nn.sigmoid(block_diag_linear(xf, w_x.astype(jnp.float32)) + b_x.astype(jnp.float32))
    log_a = -LRU_C * r * jax.nn.softplus(-lam.astype(jnp.float32))
    a = jnp.exp(log_a)
    u = jnp.sqrt(-jnp.expm1(2.0 * log_a)) * (i * xf)

    def combine(left, right):
        a_l, u_l = left
        a_r, u_r = right
        return a_l * a_r, a_r * u_l + u_r

    _, h = lax.associative_scan(combine, (a, u), axis=1)
    return h


def segsum(x):
    t = x.shape[-1]
    cs = jnp.cumsum(x, axis=-1)
    diff = cs[..., :, None] - cs[..., None, :]
    mask = jnp.tril(jnp.ones((t, t), dtype=bool))
    return jnp.where(mask, diff, -jnp.inf)


def ssd_chunked(x, dt, a, bm, cm):
    bsz, seq, nh, hp = x.shape
    ng, ns = bm.shape[-2:]
    ne = nh // ng
    nc = seq // SSD_CHUNK
    ln = SSD_CHUNK
    xc = (x * dt[..., None]).reshape(bsz, nc, ln, ng, ne, hp)
    bc = bm.reshape(bsz, nc, ln, ng, ns)
    cc = cm.reshape(bsz, nc, ln, ng, ns)
    ac = (dt * a).reshape(bsz, nc, ln, ng, ne).transpose(0, 3, 4, 1, 2)
    acs = jnp.cumsum(ac, axis=-1)
    decay_in = jnp.exp(segsum(ac))
    cb = jnp.einsum('bclgn,bcsgn->bgcls', cc, bc)
    y_diag = jnp.einsum('bgecls,bcsgep->bclgep', cb[:, :, None] * decay_in, xc)
    decay_states = jnp.exp(acs[..., -1:] - acs).transpose(0, 3, 4, 1, 2)
    states = jnp.einsum('bclgn,bclgep->bcgepn', bc, xc * decay_states[..., None])
    chunk_tot = jnp.pad(acs[..., -1], ((0, 0), (0, 0), (0, 0), (1, 0)))
    decay_chunk = jnp.exp(segsum(chunk_tot))
    states = jnp.pad(states, ((0, 0), (1, 0), (0, 0), (0, 0), (0, 0), (0, 0)))
    prev_states = jnp.einsum('bgezj,bjgepn->bzgepn', decay_chunk, states)[:, :-1]
    decay_out = jnp.exp(acs).transpose(0, 3, 4, 1, 2)
    y_off = jnp.einsum('bclgn,bcgepn->bclgep', cc, prev_states) * decay_out[..., None]
    return (y_diag + y_off).reshape(bsz, seq, nh, hp)


def mlstm_chunkwise(q, k, v, i_pre, f_pre):
    bsz, nh, seq, dh = q.shape
    nc = seq // MLSTM_CHUNK
    ln = MLSTM_CHUNK
    k = k * (dh ** -0.5)
    log_f = jax.nn.log_sigmoid(f_pre)

    def to_chunks(t):
        return jnp.moveaxis(t.reshape((bsz, nh, nc, ln) + t.shape[3:]), 2, 0)

    causal = jnp.tril(jnp.ones((ln, ln), dtype=bool))

    def step(carry, inp):
        c_st, n_st, m_st = carry
        q_c, k_c, v_c, i_c, lf_c = inp
        bcum = jnp.cumsum(lf_c, axis=-1)
        log_d = jnp.where(causal, bcum[..., :, None] - bcum[..., None, :] + i_c[..., None, :], -jnp.inf)
        g = bcum + m_st[..., None]
        m = jnp.maximum(g, jnp.max(log_d, axis=-1))
        w_inter = jnp.exp(g - m)
        s_mat = jnp.einsum('bhtd,bhsd->bhts', q_c, k_c) * jnp.exp(log_d - m[..., None])
        num = w_inter[..., None] * jnp.einsum('bhtd,bhdv->bhtv', q_c, c_st) + jnp.einsum('bhts,bhsv->bhtv', s_mat, v_c)
        den = w_inter * jnp.einsum('bhtd,bhd->bht', q_c, n_st) + jnp.sum(s_mat, axis=-1)
        h_out = num / jnp.maximum(jnp.abs(den), jnp.exp(-m))[..., None]
        b_last = bcum[..., -1]
        log_w = b_last[..., None] - bcum + i_c
        m_new = jnp.maximum(b_last + m_st, jnp.max(log_w, axis=-1))
        w_s = jnp.exp(log_w - m_new[..., None])
        decay = jnp.exp(b_last + m_st - m_new)
        c_new = decay[..., None, None] * c_st + jnp.einsum('bhs,bhsd,bhsv->bhdv', w_s, k_c, v_c)
        n_new = decay[..., None] * n_st + jnp.einsum('bhs,bhsd->bhd', w_s, k_c)
        return (c_new, n_new, m_new), h_out

    init = (jnp.zeros((bsz, nh, dh, dh), jnp.float32), jnp.zeros((bsz, nh, dh), jnp.float32),
            jnp.zeros((bsz, nh), jnp.float32))
    _, hc = lax.scan(step, init, (to_chunks(q), to_chunks(k), to_chunks(v), to_chunks(i_pre), to_chunks(log_f)))
    return jnp.moveaxis(hc, 0, 2).reshape(bsz, nh, seq, dh)


def hybrid_mixer(h, w_in, w_out, lru_conv_w, lru_conv_b, lru_wa, lru_ba, lru_wx, lru_bx, lru_lambda,
                 ssd_conv_w, ssd_conv_b, ssd_dt_bias, ssd_a_log, ssd_d, ssd_norm_g):
    bsz, seq, _ = h.shape
    f32 = jnp.float32
    gate_lru, x_lru, z_ssd, xbc, dt_raw = jnp.split(h @ w_in, HYB_SPLITS, axis=-1)
    x_lru = causal_conv(x_lru, lru_conv_w, lru_conv_b)
    y_lru = rg_lru(x_lru, lru_wa, lru_ba, lru_wx, lru_bx, lru_lambda) * jax.nn.gelu(gate_lru.astype(f32))
    xbc = jax.nn.silu(causal_conv(xbc, ssd_conv_w, ssd_conv_b)).astype(f32)
    gn = SSD_GROUPS * SSD_STATE
    xs = xbc[..., :SSD_WIDTH].reshape(bsz, seq, SSD_HEADS, SSD_HEADDIM)
    bm = xbc[..., SSD_WIDTH:SSD_WIDTH + gn].reshape(bsz, seq, SSD_GROUPS, SSD_STATE)
    cm = xbc[..., SSD_WIDTH + gn:].reshape(bsz, seq, SSD_GROUPS, SSD_STATE)
    dt = jax.nn.softplus(dt_raw.astype(f32) + ssd_dt_bias.astype(f32))
    a = -jnp.exp(ssd_a_log.astype(f32))
    y = ssd_chunked(xs, dt, a, bm, cm) + ssd_d.astype(f32)[:, None] * xs
    y = y.reshape(bsz, seq, SSD_WIDTH) * jax.nn.silu(z_ssd.astype(f32))
    y = rms_norm(y.reshape(bsz, seq, SSD_GROUPS, SSD_WIDTH // SSD_GROUPS),
                 ssd_norm_g.reshape(SSD_GROUPS, SSD_WIDTH // SSD_GROUPS)).reshape(bsz, seq, SSD_WIDTH)
    y_cat = jnp.concatenate([y_lru, y], axis=-1).astype(h.dtype)
    return y_cat @ w_out


def mlstm_block(h, w_up, conv_w, conv_b, wq, wk, wv, w_gates, b_gates, norm_g, skip, w_down):
    bsz, seq, _ = h.shape
    f32 = jnp.float32
    xm, z = jnp.split(h @ w_up, 2, axis=-1)
    xc = jax.nn.silu(causal_conv(xm, conv_w, conv_b))
    q = block_diag_linear(xc, wq)
    k = block_diag_linear(xc, wk)
    v = block_diag_linear(xm, wv)
    gates = (q @ w_gates[:MLSTM_WIDTH] + k @ w_gates[MLSTM_WIDTH:2 * MLSTM_WIDTH]
             + v @ w_gates[2 * MLSTM_WIDTH:] + b_gates).astype(f32).transpose(0, 2, 1)
    i_pre = gates[:, :MLSTM_HEADS]
    f_pre = gates[:, MLSTM_HEADS:]

    def heads(t):
        return t.astype(f32).reshape(bsz, seq, MLSTM_HEADS, MLSTM_HEADDIM).transpose(0, 2, 1, 3)

    hh = mlstm_chunkwise(heads(q), heads(k), heads(v), i_pre, f_pre)
    hh = head_layer_norm(hh.transpose(0, 2, 1, 3), norm_g.reshape(MLSTM_HEADS, MLSTM_HEADDIM))
    hh = hh.reshape(bsz, seq, MLSTM_WIDTH) + skip.astype(f32) * xc.astype(f32)
    return (hh * jax.nn.silu(z.astype(f32))).astype(h.dtype) @ w_down


def setup_inputs(seed: int = 0) -> dict:
    key = jax.random.key(seed)
    ks = iter(jax.random.split(key, 64))
    f32 = jnp.float32

    def nrm(shape, fan_in, scale=1.0):
        return jax.random.normal(next(ks), shape, f32) * (scale * fan_in ** -0.5)

    def small(shape, s=0.02):
        return jax.random.normal(next(ks), shape, f32) * s

    def gain(shape):
        return 1.0 + small(shape, 0.05)

    x = jax.random.normal(next(ks), (BATCH, SEQ, D_MODEL), f32)
    c = jax.random.normal(next(ks), (BATCH, D_MODEL), f32)
    ada_w = nrm((DEPTH, D_MODEL, N_SUB * 3 * D_MODEL), D_MODEL, 0.5)
    ada_b = small((DEPTH, N_SUB * 3 * D_MODEL))
    norm_g = gain((DEPTH, N_SUB, D_MODEL))
    ffn_w_gate = nrm((DEPTH, 2, D_MODEL, D_FF), D_MODEL)
    ffn_w_up = nrm((DEPTH, 2, D_MODEL, D_FF), D_MODEL)
    ffn_w_down = nrm((DEPTH, 2, D_FF, D_MODEL), D_FF)
    hyb_w_in = nrm((N_EVEN, D_MODEL, HYB_IN), D_MODEL)
    hyb_w_out = nrm((N_EVEN, HYB_OUT, D_MODEL), HYB_OUT)
    lru_conv_w = nrm((N_EVEN, CONV_WIDTH, LRU_WIDTH), CONV_WIDTH)
    lru_conv_b = small((N_EVEN, LRU_WIDTH))
    lru_wa = nrm((N_EVEN, LRU_HEADS, LRU_BLOCK, LRU_BLOCK), LRU_BLOCK)
    lru_ba = small((N_EVEN, LRU_WIDTH))
    lru_wx = nrm((N_EVEN, LRU_HEADS, LRU_BLOCK, LRU_BLOCK), LRU_BLOCK)
    lru_bx = small((N_EVEN, LRU_WIDTH))
    a_pow = jax.random.uniform(next(ks), (N_EVEN, LRU_WIDTH), f32, minval=0.9, maxval=0.999)
    s_a = a_pow ** (1.0 / LRU_C)
    lru_lambda = jnp.log(s_a) - jnp.log1p(-s_a)
    ssd_conv_w = nrm((N_EVEN, CONV_WIDTH, SSD_CONV_DIM), CONV_WIDTH)
    ssd_conv_b = small((N_EVEN, SSD_CONV_DIM))
    dt0 = jnp.exp(jax.random.uniform(next(ks), (N_EVEN, SSD_HEADS), f32,
                                     minval=float(np.log(1e-3)), maxval=float(np.log(1e-1))))
    ssd_dt_bias = dt0 + jnp.log(-jnp.expm1(-dt0))
    ssd_a_log = jnp.log(jax.random.uniform(next(ks), (N_EVEN, SSD_HEADS), f32, minval=1.0, maxval=16.0))
    ssd_d = gain((N_EVEN, SSD_HEADS))
    ssd_norm_g = gain((N_EVEN, SSD_WIDTH))
    mlstm_w_up = nrm((N_ODD, D_MODEL, 2 * MLSTM_WIDTH), D_MODEL)
    mlstm_conv_w = nrm((N_ODD, CONV_WIDTH, MLSTM_WIDTH), CONV_WIDTH)
    mlstm_conv_b = small((N_ODD, MLSTM_WIDTH))
    nblk = MLSTM_WIDTH // MLSTM_QKV_BLOCK
    mlstm_wq = nrm((N_ODD, nblk, MLSTM_QKV_BLOCK, MLSTM_QKV_BLOCK), MLSTM_QKV_BLOCK)
    mlstm_wk = nrm((N_ODD, nblk, MLSTM_QKV_BLOCK, MLSTM_QKV_BLOCK), MLSTM_QKV_BLOCK)
    mlstm_wv = nrm((N_ODD, nblk, MLSTM_QKV_BLOCK, MLSTM_QKV_BLOCK), MLSTM_QKV_BLOCK)
    mlstm_w_gates = nrm((N_ODD, 3 * MLSTM_WIDTH, 2 * MLSTM_HEADS), 3 * MLSTM_WIDTH, 0.5)
    f_bias = jnp.broadcast_to(jnp.linspace(3.0, 6.0, MLSTM_HEADS, dtype=f32), (N_ODD, MLSTM_HEADS))
    mlstm_b_gates = jnp.concatenate([small((N_ODD, MLSTM_HEADS), 0.1),
                                     f_bias + small((N_ODD, MLSTM_HEADS), 0.02)], axis=-1)
    mlstm_norm_g = gain((N_ODD, MLSTM_WIDTH))
    mlstm_skip = gain((N_ODD, MLSTM_WIDTH))
    mlstm_w_down = nrm((N_ODD, MLSTM_WIDTH, D_MODEL), MLSTM_WIDTH)
    final_norm_g = gain((D_MODEL,))
    return {'x': x, 'c': c, 'ada_w': ada_w, 'ada_b': ada_b, 'norm_g': norm_g,
            'ffn_w_gate': ffn_w_gate, 'ffn_w_up': ffn_w_up, 'ffn_w_down': ffn_w_down,
            'hyb_w_in': hyb_w_in, 'hyb_w_out': hyb_w_out,
            'lru_conv_w': lru_conv_w, 'lru_conv_b': lru_conv_b, 'lru_wa': lru_wa, 'lru_ba': lru_ba,
            'lru_wx': lru_wx, 'lru_bx': lru_bx, 'lru_lambda': lru_lambda,
            'ssd_conv_w': ssd_conv_w, 'ssd_conv_b': ssd_conv_b, 'ssd_dt_bias': ssd_dt_bias,
            'ssd_a_log': ssd_a_log, 'ssd_d': ssd_d, 'ssd_norm_g': ssd_norm_g,
            'mlstm_w_up': mlstm_w_up, 'mlstm_conv_w': mlstm_conv_w, 'mlstm_conv_b': mlstm_conv_b,
            'mlstm_wq': mlstm_wq, 'mlstm_wk': mlstm_wk, 'mlstm_wv': mlstm_wv,
            'mlstm_w_gates': mlstm_w_gates, 'mlstm_b_gates': mlstm_b_gates,
            'mlstm_norm_g': mlstm_norm_g, 'mlstm_skip': mlstm_skip, 'mlstm_w_down': mlstm_w_down,
            'final_norm_g': final_norm_g}


def reference(x, c, ada_w, ada_b, norm_g, ffn_w_gate, ffn_w_up, ffn_w_down, hyb_w_in, hyb_w_out,
              lru_conv_w, lru_conv_b, lru_wa, lru_ba, lru_wx, lru_bx, lru_lambda,
              ssd_conv_w, ssd_conv_b, ssd_dt_bias, ssd_a_log, ssd_d, ssd_norm_g,
              mlstm_w_up, mlstm_conv_w, mlstm_conv_b, mlstm_wq, mlstm_wk, mlstm_wv,
              mlstm_w_gates, mlstm_b_gates, mlstm_norm_g, mlstm_skip, mlstm_w_down, final_norm_g):
    bsz = x.shape[0]
    c_act = jax.nn.silu(c)
    for layer in range(DEPTH):
        mod = (c_act @ ada_w[layer] + ada_b[layer]).reshape(bsz, N_SUB, 3, D_MODEL)[:, :, :, None, :]

        def modulate(t, sub):
            return rms_norm(t, norm_g[layer, sub]) * (1.0 + mod[:, sub, 1]) + mod[:, sub, 0]

        h = modulate(x, 0)
        x = x + HALF_STEP * (1.0 + mod[:, 0, 2]) * swiglu(h, ffn_w_gate[layer, 0], ffn_w_up[layer, 0], ffn_w_down[layer, 0])
        h = modulate(x, 1)
        if layer % 2 == 0:
            e = layer // 2
            y = hybrid_mixer(h, hyb_w_in[e], hyb_w_out[e], lru_conv_w[e], lru_conv_b[e], lru_wa[e], lru_ba[e],
                             lru_wx[e], lru_bx[e], lru_lambda[e], ssd_conv_w[e], ssd_conv_b[e],
                             ssd_dt_bias[e], ssd_a_log[e], ssd_d[e], ssd_norm_g[e])
        else:
            o = layer // 2
            y = mlstm_block(h, mlstm_w_up[o], mlstm_conv_w[o], mlstm_conv_b[o], mlstm_wq[o], mlstm_wk[o],
                            mlstm_wv[o], mlstm_w_gates[o], mlstm_b_gates[o], mlstm_norm_g[o],
                            mlstm_skip[o], mlstm_w_down[o])
        x = x + (1.0 + mod[:, 1, 2]) * y.astype(x.dtype)
        h = modulate(x, 2)
        x = x + HALF_STEP * (1.0 + mod[:, 2, 2]) * swiglu(h, ffn_w_gate[layer, 1], ffn_w_up[layer, 1], ffn_w_down[layer, 1])
    return rms_norm(x, final_norm_g)
```

```cpp
#include <hip/hip_runtime.h>
#include <hip/hip_cooperative_groups.h>
#include <cstdio>
namespace cg = cooperative_groups;
#define LAS __attribute__((address_space(3)))
typedef unsigned short bf16_t;
typedef short bf16x8 __attribute__((ext_vector_type(8)));
typedef float f32x4 __attribute__((ext_vector_type(4)));
typedef float f32x2 __attribute__((ext_vector_type(2)));
typedef unsigned u32x4 __attribute__((ext_vector_type(4)));
typedef unsigned u32x2 __attribute__((ext_vector_type(2)));
#define MIB (1048576ull)
constexpr int T_TOK = 32768, SEQL = 8192;
constexpr size_t W_GU0 = 0, W_GU1 = 11 * MIB, W_DN0 = 22 * MIB, W_DN1 = 27 * MIB + 524288, W_X0 = 33 * MIB, W_HOUT = 42 * MIB + 524288, W_MLDN = 41 * MIB, W_LRU = 46 * MIB + 524288;
constexpr size_t S_BASE = 48 * MIB, S_MOD = S_BASE, S_WEFF = S_BASE + 524288, S_GQK = S_BASE + 786432, S_CHTOT = S_BASE + 851968, S_RSTD = S_BASE + MIB;
constexpr size_t AR = 50 * MIB, A_PROJ = AR, A_H = AR + 288 * MIB, A_ST = AR + 352 * MIB, A_DT = AR + 416 * MIB;
constexpr size_t A_XC = AR + 256 * MIB, A_SI = AR + 384 * MIB, A_GP = AR + 400 * MIB, A_AUX = AR + 404 * MIB;
constexpr int PROJ_LD = 4608, ACT_LD = 2944, XB_LD = 2048, XB_OFF = 1024;

__device__ __forceinline__ int TID() { int t = threadIdx.x; asm volatile("" : "+v"(t)); return t; }
__device__ __forceinline__ int BID() { int t = blockIdx.x; asm volatile("" : "+s"(t)); return t; }
__device__ __forceinline__ int GDIM() { int t = gridDim.x; asm volatile("" : "+s"(t)); return t; }
struct Params { const float* in[35]; float* out; unsigned char* ws; };

__device__ __forceinline__ float bf2f(unsigned short v) { return __uint_as_float(((unsigned)v) << 16); }
typedef __bf16 bf16n2 __attribute__((ext_vector_type(2)));
__device__ __forceinline__ unsigned pk2(float lo, float hi) { const f32x2 v = {lo, hi}; const bf16n2 r = __builtin_convertvector(v, bf16n2); return __builtin_bit_cast(unsigned, r); }
__device__ __forceinline__ float siluf(float x) { return x * __builtin_amdgcn_rcpf(1.f + __expf(-x)); }
__device__ __forceinline__ float sigmf(float x) { return __builtin_amdgcn_rcpf(1.f + __expf(-x)); }
__device__ __forceinline__ float softplusf(float x) { return fmaxf(x, 0.f) + __logf(1.0f + __expf(-fabsf(x))); }
__device__ __forceinline__ float gelu_tanh(float x) { float u = 0.7978845608f * (x + 0.044715f * x * x * x); float e = __expf(2.f * u); float th = 1.f - 2.f * __builtin_amdgcn_rcpf(e + 1.f); return 0.5f * x * (1.f + th); }
#define UNPACK8(v, f) do { f[0] = __uint_as_float((v).x << 16); f[1] = __uint_as_float((v).x & 0xffff0000u); f[2] = __uint_as_float((v).y << 16); f[3] = __uint_as_float((v).y & 0xffff0000u); \
  f[4] = __uint_as_float((v).z << 16); f[5] = __uint_as_float((v).z & 0xffff0000u); f[6] = __uint_as_float((v).w << 16); f[7] = __uint_as_float((v).w & 0xffff0000u); } while (0)
#define PACK8(f) ((u32x4){pk2(f[0], f[1]), pk2(f[2], f[3]), pk2(f[4], f[5]), pk2(f[6], f[7])})

namespace pg8 {
constexpr int BM = 256, BK = 64, HALF = 128, HTB = HALF * BK * 2, STAGE_BYTES = 8 * HTB, NXCD = 8, WGM = 8;
__device__ __forceinline__ int lds_byte(int r, int c) { const int st = (r >> 4) * 2 + (c >> 5), rr = r & 15, cc = c & 31, ob = rr * 64 + cc * 2; return st * 1024 + (ob ^ (((ob >> 9) & 1) << 5)); }
__device__ __forceinline__ void stage_rc(int b, int& R, int& C) { const int st = b / 1024, sb = b % 1024, swz = sb ^ (((sb >> 9) & 1) << 5); R = (st >> 1) * 16 + swz / 64; C = (st & 1) * 32 + (swz % 64) / 2; }
__device__ __forceinline__ int perm32(int rho) { const int n = rho >> 4, i = rho & 15; return 8 * (i >> 2) + 4 * n + (i & 3); }
struct Unit { int pm, pn; };
struct Gemm { const bf16_t* A; const bf16_t* Bt; int M, N, K, lda, akoff; };
struct StaticOrder {
    int nM, nN, nwg, G, c;
    __device__ void init(int M, int N, int G_, int c_) { nM = M / BM; nN = N / BM; nwg = nM * nN; G = G_; c = c_; }
    __device__ bool next(int i, Unit& u) const {
        const long L = (long)i * G + c; if (L >= nwg) return false;
        int wgid = (int)L; { const int q = nwg / NXCD, r = nwg % NXCD, xcd = wgid % NXCD, off = wgid / NXCD; wgid = (xcd < r ? xcd * (q + 1) : r * (q + 1) + (xcd - r) * q) + off; }
        const int nig = WGM * nN, gid = wgid / nig, fm = gid * WGM, gsz = (nM - fm) < WGM ? (nM - fm) : WGM;
        u.pm = fm + ((wgid % nig) % gsz); u.pn = (wgid % nig) / gsz; return true;
    }
};
template <class Epi>
__device__ __forceinline__ void gemm_phase(LAS unsigned char* lds, const Gemm g, const Epi& E) {
    StaticOrder S; S.init(g.M, g.N, (int)GDIM(), (int)BID());
    const int tid = TID(), wid = __builtin_amdgcn_readfirstlane(tid >> 6), lane = tid & 63, wr = wid >> 2, wc = wid & 3, fr = lane & 15, fq = lane >> 4;
    const int K = g.K, nt = K / BK;
    unsigned voffA[2], voffB[2];
#pragma unroll
    for (int i = 0; i < 2; ++i) { int R, C; stage_rc(tid * 16 + i * 8192, R, C); const int Rb = Epi::PERM ? ((R & ~31) + perm32(R & 31)) : R;
        voffA[i] = (unsigned)(R * g.lda + C) * 2u; voffB[i] = (unsigned)(Rb * K + C) * 2u; }
    const size_t kstep = (size_t)(BK * 2);
    const size_t hstepA = (size_t)HALF * g.lda * 2, hstepB = (size_t)HALF * K * 2;
    const size_t tstepA = 2 * hstepA, tstepB = 2 * hstepB;
    const unsigned ldsw = (unsigned)wid * 1024u;
    const int aoff = lds_byte(wr * 64 + fr, fq * 8), boff = lds_byte(wc * 32 + fr, fq * 8);
#define PG8_SA(b, h) (((b) * 2 + (h)) * HTB)
#define PG8_SB(b, h) ((4 + (b) * 2 + (h)) * HTB)
#define PG8_STAGE(bufoff, gbase, voff) do { _Pragma("unroll") for (int _i = 0; _i < 2; ++_i) \
        __builtin_amdgcn_global_load_lds((const unsigned*)((const char*)(gbase) + (voff)[_i]), (LAS unsigned*)(lds + (bufoff) + ldsw + _i * 8192), 16, 0, 0); } while (0)
#define PG8_LDA(dst, b, h) do { _Pragma("unroll") for (int m = 0; m < 4; ++m) _Pragma("unroll") for (int k = 0; k < 2; ++k) dst[m][k] = *(const LAS bf16x8*)(lds + PG8_SA(b, h) + aoff + m * 2048 + k * 1024); } while (0)
#define PG8_LDB(dst, b, h) do { _Pragma("unroll") for (int n = 0; n < 2; ++n) _Pragma("unroll") for (int k = 0; k < 2; ++k) dst[n][k] = *(const LAS bf16x8*)(lds + PG8_SB(b, h) + boff + n * 2048 + k * 1024); } while (0)
#define PG8_MMA(ai, bj, At, Bt) do { __builtin_amdgcn_s_setprio(1); _Pragma("unroll") for (int m = 0; m < 4; ++m) _Pragma("unroll") for (int n = 0; n < 2; ++n) _Pragma("unroll") for (int k = 0; k < 2; ++k) \
        acc[ai][bj][m][n] = __builtin_amdgcn_mfma_f32_16x16x32_bf16(Bt[n][k], At[m][k], acc[ai][bj][m][n], 0, 0, 0); __builtin_amdgcn_s_setprio(0); } while (0)
#define PG8_WAIT_V(n) asm volatile("s_waitcnt vmcnt(" #n ")" ::: "memory")
#define PG8_WAIT_L(n) asm volatile("s_waitcnt lgkmcnt(" #n ")" ::: "memory")
#define PG8_BAR __builtin_amdgcn_s_barrier()
#define PG8_SCHED __builtin_amdgcn_sched_barrier(0)
    Unit cur, nxt; int ui = 0;
    if (!S.next(0, cur)) return;
    f32x4 acc[2][2][4][2];
#pragma unroll
    for (int a = 0; a < 2; ++a)
#pragma unroll
        for (int b = 0; b < 2; ++b)
#pragma unroll
            for (int m = 0; m < 4; ++m)
#pragma unroll
                for (int n = 0; n < 2; ++n) acc[a][b][m][n] = (f32x4){0.f, 0.f, 0.f, 0.f};
    bf16x8 At[4][2], B0[2][2], B1[2][2];
    const char* cA = (const char*)g.A + (size_t)cur.pm * tstepA + (size_t)((cur.pn >> 1) * g.akoff) * 2; const char* cB = (const char*)g.Bt + (size_t)cur.pn * tstepB;
    PG8_STAGE(PG8_SB(0, 0), cB, voffB); PG8_STAGE(PG8_SA(0, 0), cA, voffA); PG8_STAGE(PG8_SB(0, 1), cB + hstepB, voffB); PG8_STAGE(PG8_SA(0, 1), cA + hstepA, voffA);
    if (wr == 1) PG8_BAR;
    PG8_WAIT_V(4); PG8_BAR;
    PG8_STAGE(PG8_SB(1, 0), cB + kstep, voffB); PG8_STAGE(PG8_SA(1, 0), cA + kstep, voffA); PG8_STAGE(PG8_SB(1, 1), cB + hstepB + kstep, voffB);
    PG8_WAIT_V(6); PG8_BAR;
    for (;;) {
        const bool has_next = S.next(ui + 1, nxt);
        const char* nA = has_next ? (const char*)g.A + (size_t)nxt.pm * tstepA + (size_t)((nxt.pn >> 1) * g.akoff) * 2 : cA; const char* nB = has_next ? (const char*)g.Bt + (size_t)nxt.pn * tstepB : cB;
        for (int t = 0; t < nt; t += 2) {
            const bool last = (t == nt - 2);
            const char* a1 = cA + (size_t)(t + 1) * kstep;
            const char* a2 = last ? nA : cA + (size_t)(t + 2) * kstep; const char* b2 = last ? nB : cB + (size_t)(t + 2) * kstep;
            const char* a3 = a2 + kstep; const char* b3 = b2 + kstep;
            PG8_LDB(B0, 0, 0); PG8_SCHED; PG8_LDA(At, 0, 0); PG8_STAGE(PG8_SA(1, 1), a1 + hstepA, voffA);
            PG8_WAIT_L(8); PG8_BAR; PG8_WAIT_L(0); PG8_MMA(0, 0, At, B0); PG8_BAR; PG8_SCHED;
            PG8_LDB(B1, 0, 1); PG8_STAGE(PG8_SB(0, 0), b2, voffB);
            PG8_BAR; PG8_WAIT_L(0); PG8_MMA(0, 1, At, B1); PG8_BAR;
            PG8_LDA(At, 0, 1); PG8_STAGE(PG8_SA(0, 0), a2, voffA);
            PG8_BAR; PG8_WAIT_L(0); PG8_MMA(1, 0, At, B0); PG8_BAR; PG8_SCHED;
            PG8_STAGE(PG8_SB(0, 1), b2 + hstepB, voffB);
            PG8_WAIT_V(6); PG8_BAR; PG8_MMA(1, 1, At, B1); PG8_BAR;
            PG8_LDB(B0, 1, 0); PG8_SCHED; PG8_LDA(At, 1, 0); PG8_STAGE(PG8_SA(0, 1), a2 + hstepA, voffA);
            PG8_WAIT_L(8); PG8_BAR; PG8_WAIT_L(0); PG8_MMA(0, 0, At, B0); PG8_BAR; PG8_SCHED;
            PG8_LDB(B1, 1, 1); PG8_STAGE(PG8_SB(1, 0), b3, voffB);
            PG8_BAR; PG8_WAIT_L(0); PG8_MMA(0, 1, At, B1); PG8_BAR;
            PG8_LDA(At, 1, 1); PG8_STAGE(PG8_SA(1, 0), a3, voffA);
            PG8_BAR; PG8_WAIT_L(0); PG8_MMA(1, 0, At, B0); PG8_BAR; PG8_SCHED;
            PG8_STAGE(PG8_SB(1, 1), b3 + hstepB, voffB);
            PG8_WAIT_V(6); PG8_BAR; PG8_MMA(1, 1, At, B1); PG8_BAR;
        }
        E(acc, cur, wr, wc, fr, fq);
        if (!has_next) break;
#pragma unroll
        for (int a = 0; a < 2; ++a)
#pragma unroll
            for (int b = 0; b < 2; ++b)
#pragma unroll
                for (int m = 0; m < 4; ++m)
#pragma unroll
                    for (int n = 0; n < 2; ++n) acc[a][b][m][n] = (f32x4){0.f, 0.f, 0.f, 0.f};
        cur = nxt; cA = nA; cB = nB; ++ui;
    }
    PG8_WAIT_V(0);
    if (wr == 0) PG8_BAR;
    PG8_BAR;
}
}
using pg8::Unit;
typedef f32x4 AccT[2][2][4][2];

struct EpiSwiglu { static constexpr bool PERM = true; bf16_t* O;
    __device__ __forceinline__ void operator()(const AccT& acc, const Unit& u, int wr, int wc, int fr, int fq) const {
        const int row0 = u.pm * 256 + wr * 64 + fr, col = u.pn * 128 + wc * 32 + 8 * fq;
#pragma unroll
        for (int ai = 0; ai < 2; ++ai)
#pragma unroll
            for (int m = 0; m < 4; ++m) {
                float v[8];
#pragma unroll
                for (int n = 0; n < 2; ++n)
#pragma unroll
                    for (int j = 0; j < 4; ++j) v[4 * n + j] = siluf(acc[ai][0][m][n][j]) * acc[ai][1][m][n][j];
                *(u32x4*)(O + (size_t)(row0 + ai * 128 + m * 16) * ACT_LD + col) = PACK8(v);
            }
    } };
template <bool SRCF32> struct EpiResidT { static constexpr bool PERM = true; const void* src; bf16_t* dst; const float* gate; float coef;
    __device__ __forceinline__ void operator()(const AccT& acc, const Unit& u, int wr, int wc, int fr, int fq) const {
        const int row0 = u.pm * 256 + wr * 64 + fr, col0 = u.pn * 256 + wc * 32 + 8 * fq;
        const float* gp = gate + (size_t)(u.pm >> 5) * 9216 + col0;
        f32x4 gv[2][2];
#pragma unroll
        for (int bj = 0; bj < 2; ++bj)
#pragma unroll
            for (int n = 0; n < 2; ++n) gv[bj][n] = (*(const f32x4*)(gp + bj * 128 + n * 4) + 1.0f) * coef;
#pragma unroll
        for (int ai = 0; ai < 2; ++ai)
#pragma unroll
            for (int m = 0; m < 4; ++m) { const size_t rr = (size_t)(row0 + ai * 128 + m * 16);
#pragma unroll
                for (int bj = 0; bj < 2; ++bj) { const size_t o = rr * XB_LD + col0 + bj * 128; float xv[8], y[8];
                    if (SRCF32) { const size_t of = rr * 1024 + col0 + bj * 128; const f32x4 a = *(const f32x4*)((const float*)src + of), b = *(const f32x4*)((const float*)src + of + 4);
#pragma unroll
                        for (int e = 0; e < 4; ++e) { xv[e] = a[e]; xv[4 + e] = b[e]; } }
                    else { const u32x4 r = *(const u32x4*)((const bf16_t*)src + o); UNPACK8(r, xv); }
#pragma unroll
                    for (int n = 0; n < 2; ++n)
#pragma unroll
                        for (int jj = 0; jj < 4; ++jj) y[4 * n + jj] = xv[4 * n + jj] + gv[bj][n][jj] * acc[ai][bj][m][n][jj];
                    *(u32x4*)(dst + o) = PACK8(y); } }
    } };
struct EpiProj { static constexpr bool PERM = true; bf16_t* O; int ldc; int dt_pn; float* dt;
    __device__ __forceinline__ void operator()(const AccT& acc, const Unit& u, int wr, int wc, int fr, int fq) const {
        const int row0 = u.pm * 256 + wr * 64 + fr;
        if (u.pn == dt_pn) {
            if (wc == 0 && fq < 2) {
#pragma unroll
                for (int ai = 0; ai < 2; ++ai)
#pragma unroll
                    for (int m = 0; m < 4; ++m)
#pragma unroll
                        for (int n = 0; n < 2; ++n) *(f32x4*)(dt + (size_t)(row0 + ai * 128 + m * 16) * 16 + 8 * fq + 4 * n) = acc[ai][0][m][n];
            }
            return;
        }
        const int col = u.pn * 256 + wc * 32 + 8 * fq;
#pragma unroll
        for (int ai = 0; ai < 2; ++ai)
#pragma unroll
            for (int m = 0; m < 4; ++m)
#pragma unroll
                for (int bj = 0; bj < 2; ++bj) {
                    float v[8];
#pragma unroll
                    for (int n = 0; n < 2; ++n)
#pragma unroll
                        for (int j = 0; j < 4; ++j) v[4 * n + j] = acc[ai][bj][m][n][j];
                    *(u32x4*)(O + (size_t)(row0 + ai * 128 + m * 16) * ldc + col + bj * 128) = PACK8(v);
                }
    } };
struct EpiLru { static constexpr bool PERM = true; bf16_t* proj; const bf16_t* xconv; const float* ba; const float* bx; const float* lam;
    __device__ __forceinline__ void operator()(const AccT& acc, const Unit& u, int wr_, int wc_, int fr_, int fq_) const {
        const int t_ = TID(), wr = t_ >> 8, wc = (t_ >> 6) & 3, fr = t_ & 15, fq = (t_ >> 4) & 3;
        const int row0 = u.pm * 256 + wr * 64 + fr, ch0 = u.pn * 128 + wc * 32 + 8 * fq;
#pragma unroll
        for (int n = 0; n < 2; ++n) { const int ch = ch0 + 4 * n;
            const f32x4 vba = *(const f32x4*)(ba + ch), vbx = *(const f32x4*)(bx + ch), vl = *(const f32x4*)(lam + ch); f32x4 vsp;
#pragma unroll
            for (int j = 0; j < 4; ++j) vsp[j] = -8.0f * softplusf(-vl[j]);
            int rowi = row0;
#pragma unroll
            for (int ai = 0; ai < 2; ++ai)
#pragma unroll
                for (int m = 0; m < 4; ++m) {
                    asm volatile("" : "+v"(rowi));
                    const size_t row = (size_t)rowi; rowi += (m == 3) ? 80 : 16;
                    const u32x2 xr = *(const u32x2*)(xconv + row * 1024 + ch);
                    const float xv[4] = {__uint_as_float(xr.x << 16), __uint_as_float(xr.x & 0xffff0000u), __uint_as_float(xr.y << 16), __uint_as_float(xr.y & 0xffff0000u)};
                    float la[4], uu[4];
#pragma unroll
                    for (int j = 0; j < 4; ++j) { const float r = sigmf(acc[ai][0][m][n][j] + vba[j]), ig = sigmf(acc[ai][1][m][n][j] + vbx[j]);
                        const float l = r * vsp[j]; la[j] = l; uu[j] = __builtin_amdgcn_sqrtf(fmaxf(1.0f - __expf(2.0f * l), 0.f)) * ig * xv[j]; }
                    u32x2 w0; w0.x = pk2(la[0], la[1]); w0.y = pk2(la[2], la[3]); *(u32x2*)(proj + row * PROJ_LD + 3072 + ch) = w0;
                    u32x2 w1; w1.x = pk2(uu[0], uu[1]); w1.y = pk2(uu[2], uu[3]); *(u32x2*)(proj + row * PROJ_LD + 2048 + ch) = w1;
                } }
    } };
#define XB_TMO      128
#define XB_XCNT(j)  (256  + 64 * (j))
#define XB_XSUB(j)  (1280 + 64 * (j))
#define XB_XGEN(j)  (2304 + 64 * (j))
#define XB_TOP      3328
#define XB_TOPGEN   3392
#define XCD_BAR_WORDS 3456
#define XB_SPIN_CAP (1u << 20)
constexpr size_t S_BAR = S_BASE + MIB + 786432;
__device__ __forceinline__ unsigned xb_ld(unsigned* p)              { return __hip_atomic_load(p, __ATOMIC_RELAXED, __HIP_MEMORY_SCOPE_AGENT); }
__device__ __forceinline__ unsigned xb_add(unsigned* p, unsigned v) { return __hip_atomic_fetch_add(p, v, __ATOMIC_RELAXED, __HIP_MEMORY_SCOPE_AGENT); }
__device__ __forceinline__ unsigned xb_xcc_id() { return (unsigned)__builtin_amdgcn_s_getreg((3 << 11) | 20) & 0xFu; }
#define XB_SPIN(cond, bar) do { unsigned _sp = 0; while (cond) { __builtin_amdgcn_s_sleep(1); \
    if ((++_sp & 255u) == 0u) { if (xb_ld(&(bar)[XB_TMO])) break; if (_sp > XB_SPIN_CAP) { atomicAdd(&(bar)[XB_TMO], 1u); break; } } } } while (0)
struct XcdBarrier { unsigned* bar; unsigned x; volatile LAS unsigned* st; };
__device__ __forceinline__ void xcd_barrier_post(unsigned* bar) { if (threadIdx.x == 0) (void)xb_add(&bar[XB_XCNT(xb_xcc_id())], 1u); }
__device__ __forceinline__ void xcd_barrier_complete(unsigned* bar, unsigned x, unsigned& nloc, unsigned& nx) {
    const unsigned G = gridDim.x * gridDim.y * gridDim.z;
    unsigned sum, cnt, mine, sp = 0u;
    for (;;) {
        sum = 0u; cnt = 0u; mine = 0u;
#pragma unroll
        for (unsigned j = 0; j < 16; ++j) { const unsigned c = xb_ld(&bar[XB_XCNT(j)]); sum += c; cnt += (c > 0u) ? 1u : 0u; mine = (j == x) ? c : mine; }
        if (sum == G) break;
        __builtin_amdgcn_s_sleep(1);
        if ((++sp & 255u) == 0u) { if (xb_ld(&bar[XB_TMO])) break; if (sp > XB_SPIN_CAP) { atomicAdd(&bar[XB_TMO], 1u); break; } }
    }
    nloc = mine > 0u ? mine : 1u; nx = cnt > 0u ? cnt : 1u;
}
__device__ __forceinline__ void xcd_barrier(const XcdBarrier& b) {
    asm volatile("s_waitcnt vmcnt(0)" ::: "memory");
    __syncthreads();
    if (threadIdx.x == 0) {
        unsigned* bar = b.bar;
        __builtin_amdgcn_s_waitcnt(0);
        unsigned nloc = b.st[0], nx = b.st[1];
        if (nloc == 0u) { xcd_barrier_complete(bar, b.x, nloc, nx); b.st[0] = nloc; b.st[1] = nx; }
        const unsigned old = xb_add(&bar[XB_XSUB(b.x)], 1u);
        const unsigned gen = old / nloc;
        if (old + 1u == (gen + 1u) * nloc) {
            __builtin_amdgcn_fence(__ATOMIC_RELEASE, "agent");
            asm volatile("s_waitcnt vmcnt(0)" ::: "memory");
            const unsigned og = xb_add(&bar[XB_TOP], 1u);
            const unsigned tg = og / nx;
            if (og + 1u == (tg + 1u) * nx) xb_add(&bar[XB_TOPGEN], 1u);
            else XB_SPIN(xb_ld(&bar[XB_TOPGEN]) == tg, bar);
            __builtin_amdgcn_fence(__ATOMIC_ACQUIRE, "agent");
            xb_add(&bar[XB_XGEN(b.x)], 1u);
            asm volatile("s_waitcnt vmcnt(0)" ::: "memory");
        } else {
            XB_SPIN(xb_ld(&bar[XB_XGEN(b.x)]) == gen, bar);
            __builtin_amdgcn_fence(__ATOMIC_ACQUIRE, "agent");
            asm volatile("s_waitcnt vmcnt(0)" ::: "memory");
        }
    }
    __syncthreads();
}
struct CvtJob { const float* s0; const float* s1; bf16_t* dst; int K, ld, mode, tile; };
__device__ __forceinline__ CvtJob cvt_decode(const Params& p, int l, int t) {
    CvtJob j;
    if (t < 2816) { const int f = t / 1408; const size_t o = (size_t)(l * 2 + f) * 1024 * 2816; j = CvtJob{p.in[5] + o, p.in[6] + o, (bf16_t*)(p.ws + (f ? W_GU1 : W_GU0)), 1024, 2816, 1, t % 1408}; }
    else if (t < 4224) { t -= 2816; const int f = t / 704; const size_t o = (size_t)(l * 2 + f) * 1024 * 2816; j = CvtJob{p.in[7] + o, nullptr, (bf16_t*)(p.ws + (f ? W_DN1 : W_DN0)), 2816, 1024, 0, t % 704}; }
    else if (l == 0) { t -= 4224; if (t < 1216) j = CvtJob{p.in[8], nullptr, (bf16_t*)(p.ws + W_X0), 1024, 4624, 2, t}; else j = CvtJob{p.in[9], nullptr, (bf16_t*)(p.ws + W_HOUT), 2048, 1024, 0, t - 1216}; }
    else { t -= 4224; if (t < 1024) j = CvtJob{p.in[23], nullptr, (bf16_t*)(p.ws + W_X0), 1024, 4096, 0, t}; else j = CvtJob{p.in[33], nullptr, (bf16_t*)(p.ws + W_MLDN), 2048, 1024, 0, t - 1024}; }
    return j;
}
__device__ __forceinline__ void cvt_load(const CvtJob& jb, float* v) {
    const int tid = TID(); const int ktiles = jb.K >> 6; const int r0 = (jb.tile / ktiles) * 64, k0 = (jb.tile % ktiles) * 64;
    const int r = tid & 63, kk = tid >> 6, row = r0 + r; const float* pp = jb.s0 + row; bool valid = true;
    if (jb.mode == 1) { const int pn = row >> 8, bj = (row >> 7) & 1, rr = row & 127; pp = (bj ? jb.s1 : jb.s0) + pn * 128 + rr; }
    else if (jb.mode == 2) { int col = row; if (row >= 1024 && row < 2048) col = row + 1024; else if (row >= 2048 && row < 3072) col = row - 1024; valid = row < 4624; pp = jb.s0 + (valid ? col : 0); }
#pragma unroll
    for (int i = 0; i < 8; ++i) { const int k = kk + 8 * i; v[i] = valid ? pp[(size_t)(k0 + k) * jb.ld] : 0.f; }
}
__device__ __forceinline__ void cvt_store(const CvtJob& jb, const float* v, float* tl) {
    const int tid = TID(); const int ktiles = jb.K >> 6; const int r0 = (jb.tile / ktiles) * 64, k0 = (jb.tile % ktiles) * 64;
    { const int r = tid & 63, kk = tid >> 6;
#pragma unroll
      for (int i = 0; i < 8; ++i) tl[(kk + 8 * i) * 65 + r] = v[i]; }
    __syncthreads();
    { const int r = tid >> 3, kq = (tid & 7) * 8; float o[8];
#pragma unroll
      for (int e = 0; e < 8; ++e) o[e] = tl[(kq + e) * 65 + r];
      *(u32x4*)(jb.dst + (size_t)(r0 + r) * jb.K + k0 + kq) = PACK8(o); }
    __syncthreads();
}
__device__ __forceinline__ void cvt_all(const Params& p, int l, int total, float* tl) {
    int t = BID(); if (t >= total) return;
    const int G = GDIM();
    CvtJob jb = cvt_decode(p, l, t); float v[8], vn[8]; cvt_load(jb, v);
    for (;;) { const int tn = t + G; CvtJob jn = jb; const bool more = tn < total;
        if (more) { jn = cvt_decode(p, l, tn); cvt_load(jn, vn); }
        cvt_store(jb, v, tl);
        if (!more) break;
#pragma unroll
        for (int i = 0; i < 8; ++i) v[i] = vn[i];
        jb = jn; t = tn; }
}
__device__ __forceinline__ void phase_prologue(const Params& p, unsigned char* sm) {
    float* tl = (float*)sm;
    cvt_all(p, 0, 4224 + 1216 + 512, tl);
    { bf16_t* bt = (bf16_t*)(p.ws + W_LRU);
      for (int idx = BID() * 512 + TID(); idx < 2048 * 256; idx += GDIM() * 512) {
          const int row = idx >> 8, kl = idx & 255, pn = row >> 8, bj = (row >> 7) & 1, o = row & 127, kin = kl - (pn & 1) * 128;
          float v = 0.f; if (kin >= 0 && kin < 128) v = (bj ? p.in[14] : p.in[12])[(size_t)(pn * 128 + kin) * 128 + o];
          bt[idx] = (bf16_t)(pk2(v, v) & 0xffffu); } }
    { float* cact = (float*)sm; float* red = cact + 4096; float* mod = (float*)(p.ws + S_MOD);
      __syncthreads();
      for (int i = TID(); i < 4096; i += 512) cact[i] = siluf(p.in[1][i]);
      __syncthreads();
      for (int it = BID(); it < 256; it += GDIM()) {
          const int l = it >> 7, jg = it & 127, tidm = TID(), cc = tidm % 72, kp = tidm / 72, col = jg * 72 + cc;
          float a0 = 0.f, a1 = 0.f, a2 = 0.f, a3 = 0.f;
          if (kp < 7) { const int k0 = kp * 146 + (kp < 2 ? kp : 2), kn = 146 + (kp < 2 ? 1 : 0); const float* w = p.in[2] + (size_t)l * 1024 * 9216 + col;
              int k = k0;
#pragma unroll 1
              for (; k + 8 <= k0 + kn; k += 8) { float wv[8];
#pragma unroll
                  for (int i = 0; i < 8; ++i) wv[i] = w[(size_t)(k + i) * 9216];
#pragma unroll
                  for (int i = 0; i < 8; ++i) { a0 += cact[k + i] * wv[i]; a1 += cact[1024 + k + i] * wv[i]; a2 += cact[2048 + k + i] * wv[i]; a3 += cact[3072 + k + i] * wv[i]; } }
              for (; k < k0 + kn; ++k) { const float wv = w[(size_t)k * 9216]; a0 += cact[k] * wv; a1 += cact[1024 + k] * wv; a2 += cact[2048 + k] * wv; a3 += cact[3072 + k] * wv; }
              float* rp = red + (kp * 72 + cc) * 4; rp[0] = a0; rp[1] = a1; rp[2] = a2; rp[3] = a3; }
          __syncthreads();
          if (tidm < 288) { const int c2 = tidm % 72, b = tidm / 72; float sacc = p.in[3][l * 9216 + jg * 72 + c2];
#pragma unroll
              for (int q = 0; q < 7; ++q) sacc += red[(q * 72 + c2) * 4 + b];
              mod[(size_t)(l * 4 + b) * 9216 + jg * 72 + c2] = sacc; }
          __syncthreads();
      } }
}
__device__ __forceinline__ void phase_cvt_l1(const Params& p, unsigned char* sm) {
    float* tl = (float*)sm;
    cvt_all(p, 1, 4224 + 1024 + 512, tl);
    float* weff = (float*)(p.ws + S_WEFF); float* gqk = (float*)(p.ws + S_GQK);
    const float* wq = p.in[26]; const float* wk = p.in[27]; const float* wv = p.in[28]; const float* wg = p.in[29];
    for (int idx = BID() * 512 + TID(); idx < 2048 * 8; idx += GDIM() * 512) {
        const int c = idx >> 3, g = idx & 7, blk = c >> 2, i = c & 3; float s = 0.f, sv = 0.f;
#pragma unroll
        for (int o = 0; o < 4; ++o) { s += wq[blk * 16 + i * 4 + o] * wg[(size_t)(blk * 4 + o) * 8 + g] + wk[blk * 16 + i * 4 + o] * wg[(size_t)(2048 + blk * 4 + o) * 8 + g];
            sv += wv[blk * 16 + i * 4 + o] * wg[(size_t)(4096 + blk * 4 + o) * 8 + g]; }
        weff[idx] = s; weff[2048 * 8 + idx] = sv; }
    for (int idx = BID() * 512 + TID(); idx < 512 * 16; idx += GDIM() * 512) {
        const int blk = idx >> 4, i = (idx >> 2) & 3, i2 = idx & 3; float s = 0.f;
#pragma unroll
        for (int o = 0; o < 4; ++o) s += wq[blk * 16 + i * 4 + o] * wk[blk * 16 + i2 * 4 + o];
        gqk[idx] = s * 0.04419417382f; }
}
template <bool FINAL>
__device__ __forceinline__ void norm_rows(const float* x, bf16_t* h, float* xo, const float* g, const float* modl) {
    const int lane = TID() & 63, wg = BID() * 8 + (TID() >> 6), nw = GDIM() * 8;
    const int rpw = (T_TOK + nw - 1) / nw, r0 = wg * rpw, r1 = min(T_TOK, r0 + rpw);
    if (r0 >= r1) return;
    f32x4 gs[4], sh[4]; int curb = -1;
    f32x4 v[4], nx[4];
#pragma unroll
    for (int i = 0; i < 4; ++i) { v[i] = *(const f32x4*)(x + (size_t)r0 * 1024 + i * 256 + lane * 4); nx[i] = v[i]; }
    for (int row = r0; row < r1; ++row) {
        if (row + 1 < r1) {
#pragma unroll
            for (int i = 0; i < 4; ++i) nx[i] = *(const f32x4*)(x + (size_t)(row + 1) * 1024 + i * 256 + lane * 4); }
        if ((row >> 13) != curb) { curb = row >> 13;
#pragma unroll
            for (int i = 0; i < 4; ++i) { const int c = i * 256 + lane * 4; gs[i] = *(const f32x4*)(g + c);
                if (!FINAL) { const float* mb = modl + (size_t)curb * 9216; gs[i] = gs[i] * (*(const f32x4*)(mb + 1024 + c) + 1.0f); sh[i] = *(const f32x4*)(mb + c); } } }
        float ss = 0.f;
#pragma unroll
        for (int i = 0; i < 4; ++i) ss += v[i][0] * v[i][0] + v[i][1] * v[i][1] + v[i][2] * v[i][2] + v[i][3] * v[i][3];
#pragma unroll
        for (int o = 32; o >= 1; o >>= 1) ss += __shfl_xor(ss, o);
        const float rstd = rsqrtf(ss * (1.0f / 1024.0f) + 1e-6f);
#pragma unroll
        for (int i = 0; i < 4; ++i) { const int c = i * 256 + lane * 4;
            if (FINAL) { *(f32x4*)(xo + (size_t)row * 1024 + c) = v[i] * rstd * gs[i]; }
            else { const f32x4 y = v[i] * rstd * gs[i] + sh[i]; u32x2 w; w.x = pk2(y[0], y[1]); w.y = pk2(y[2], y[3]); *(u32x2*)(h + (size_t)row * 1024 + c) = w; }
            v[i] = nx[i]; }
    }
}
__device__ __forceinline__ void phase_norm(const float* x, bf16_t* h, const float* g, const float* modl) { norm_rows<false>(x, h, nullptr, g, modl); }
template <bool FINAL>
__device__ __forceinline__ void norm_rows_b(const bf16_t* x, bf16_t* h, float* out_lo, float* out_hi, const float* g, const float* modl) {
    const int lane = TID() & 63, wg = BID() * 8 + (TID() >> 6), nw = GDIM() * 8;
    const int rpw = (T_TOK + nw - 1) / nw, r0 = wg * rpw, r1 = min(T_TOK, r0 + rpw);
    if (r0 >= r1) return;
    float gs[16], sh[16]; int curb = -1;
    u32x4 v0 = *(const u32x4*)(x + (size_t)r0 * XB_LD + lane * 8), v1 = *(const u32x4*)(x + (size_t)r0 * XB_LD + 512 + lane * 8), n0 = v0, n1 = v1;
    for (int row = r0; row < r1; ++row) {
        if (row + 1 < r1) { n0 = *(const u32x4*)(x + (size_t)(row + 1) * XB_LD + lane * 8); n1 = *(const u32x4*)(x + (size_t)(row + 1) * XB_LD + 512 + lane * 8); }
        if ((row >> 13) != curb) { curb = row >> 13;
#pragma unroll
            for (int i = 0; i < 2; ++i)
#pragma unroll
                for (int q = 0; q < 2; ++q) { const int c = i * 512 + lane * 8 + q * 4; f32x4 gg = *(const f32x4*)(g + c), ss4 = (f32x4){0.f, 0.f, 0.f, 0.f};
                    if (!FINAL) { const float* mb = modl + (size_t)curb * 9216; gg = gg * (*(const f32x4*)(mb + 1024 + c) + 1.0f); ss4 = *(const f32x4*)(mb + c); }
#pragma unroll
                    for (int e = 0; e < 4; ++e) { gs[i * 8 + q * 4 + e] = gg[e]; sh[i * 8 + q * 4 + e] = ss4[e]; } } }
        float xv[16]; { float t8[8]; UNPACK8(v0, t8);
#pragma unroll
            for (int e = 0; e < 8; ++e) xv[e] = t8[e];
            UNPACK8(v1, t8);
#pragma unroll
            for (int e = 0; e < 8; ++e) xv[8 + e] = t8[e]; }
        float ss = 0.f;
#pragma unroll
        for (int e = 0; e < 16; ++e) ss += xv[e] * xv[e];
#pragma unroll
        for (int o = 32; o >= 1; o >>= 1) ss += __shfl_xor(ss, o);
        const float rstd = rsqrtf(ss * (1.0f / 1024.0f) + 1e-6f);
        if (FINAL) { float* dp = out_lo + (size_t)row * 1024;
#pragma unroll
            for (int i = 0; i < 2; ++i)
#pragma unroll
                for (int q = 0; q < 2; ++q) { f32x4 y;
#pragma unroll
                    for (int e = 0; e < 4; ++e) y[e] = xv[i * 8 + q * 4 + e] * rstd * gs[i * 8 + q * 4 + e];
                    *(f32x4*)(dp + i * 512 + lane * 8 + q * 4) = y; } }
        else {
#pragma unroll
            for (int i = 0; i < 2; ++i) { float y[8];
#pragma unroll
                for (int e = 0; e < 8; ++e) y[e] = xv[i * 8 + e] * rstd * gs[i * 8 + e] + sh[i * 8 + e];
                *(u32x4*)(h + (size_t)row * 1024 + i * 512 + lane * 8) = PACK8(y); } }
        v0 = n0; v1 = n1;
    }
}
__device__ __forceinline__ void phase_norm_b(const bf16_t* x, bf16_t* h, const float* g, const float* modl) { norm_rows_b<false>(x, h, nullptr, nullptr, g, modl); }
__device__ __forceinline__ void phase_final_norm_b(const bf16_t* x, float* out_lo, float* tmp_hi, const float* g) { norm_rows_b<true>(x, nullptr, out_lo, tmp_hi, g, nullptr); }
__device__ __forceinline__ void phase_copy_hi(const float* tmp, float* dst) {
    const size_t n4 = (size_t)16384 * 1024 / 4; const f32x4* s4 = (const f32x4*)tmp; f32x4* d4 = (f32x4*)dst;
    for (size_t i = (size_t)BID() * 512 + TID(); i < n4; i += (size_t)GDIM() * 512) d4[i] = s4[i];
}
__device__ __forceinline__ void conv8(const bf16_t* src, int ld, int tl, const float* w, int wld, const float* bias, float* out) {
    { const f32x4 b0 = *(const f32x4*)bias, b1 = *(const f32x4*)(bias + 4);
#pragma unroll
      for (int e = 0; e < 4; ++e) { out[e] = b0[e]; out[4 + e] = b1[e]; } }
#pragma unroll
    for (int k = 0; k < 4; ++k) if (tl - 3 + k >= 0) { const u32x4 r = *(const u32x4*)(src + (long)(k - 3) * ld); float v[8]; UNPACK8(r, v);
        const f32x4 w0 = *(const f32x4*)(w + k * wld), w1 = *(const f32x4*)(w + k * wld + 4);
#pragma unroll
        for (int e = 0; e < 4; ++e) { out[e] += w0[e] * v[e]; out[4 + e] += w1[e] * v[4 + e]; } }
}
__device__ __forceinline__ void conv8_load(const bf16_t* src, int ld, int tl, u32x4* r) {
#pragma unroll
    for (int k = 0; k < 4; ++k) { r[k] = (u32x4){0u, 0u, 0u, 0u}; if (tl - 3 + k >= 0) r[k] = *(const u32x4*)(src + (long)(k - 3) * ld); }
}
__device__ __forceinline__ void conv8_calc(const u32x4* r, const float* w, int wld, const float* bias, float* out) {
    { const f32x4 b0 = *(const f32x4*)bias, b1 = *(const f32x4*)(bias + 4);
#pragma unroll
      for (int e = 0; e < 4; ++e) { out[e] = b0[e]; out[4 + e] = b1[e]; } }
#pragma unroll
    for (int k = 0; k < 4; ++k) { float v[8]; UNPACK8(r[k], v);
        const f32x4 w0 = *(const f32x4*)(w + k * wld), w1 = *(const f32x4*)(w + k * wld + 4);
#pragma unroll
        for (int e = 0; e < 4; ++e) { out[e] += w0[e] * v[e]; out[4 + e] += w1[e] * v[4 + e]; } }
}
__device__ __forceinline__ void phase_lru_conv(const Params& p) {
    const bf16_t* proj = (const bf16_t*)(p.ws + A_PROJ); bf16_t* xc = (bf16_t*)(p.ws + A_H);
    const int oct = TID() & 127, sub = TID() >> 7;
    for (int t = BID() * 4 + sub; t < T_TOK; t += GDIM() * 4) {
        float o[8]; conv8(proj + (size_t)t * PROJ_LD + 2048 + oct * 8, PROJ_LD, t & (SEQL - 1), p.in[10] + oct * 8, 1024, p.in[11] + oct * 8, o);
        *(u32x4*)(xc + (size_t)t * 1024 + oct * 8) = PACK8(o);
    }
}
__device__ __forceinline__ void phase_lru_agg(const Params& p) {
    const bf16_t* proj = (const bf16_t*)(p.ws + A_PROJ); float* agg = (float*)(p.ws + A_ST);
    const int ch = TID() * 2;
    for (int u = BID(); u < 512; u += GDIM()) {
        const int t0 = u * 64; float h0 = 0.f, h1 = 0.f, l0 = 0.f, l1 = 0.f;
#pragma unroll 1
        for (int lb = 0; lb < 64; lb += 8) { unsigned la[8], uu[8];
#pragma unroll
            for (int i = 0; i < 8; ++i) { const bf16_t* row = proj + (size_t)(t0 + lb + i) * PROJ_LD; la[i] = *(const unsigned*)(row + 3072 + ch); uu[i] = *(const unsigned*)(row + 2048 + ch); }
#pragma unroll
            for (int i = 0; i < 8; ++i) { const float la0 = __uint_as_float(la[i] << 16), la1 = __uint_as_float(la[i] & 0xffff0000u);
                h0 = __expf(la0) * h0 + __uint_as_float(uu[i] << 16); h1 = __expf(la1) * h1 + __uint_as_float(uu[i] & 0xffff0000u); l0 += la0; l1 += la1; } }
        float* a = agg + (size_t)u * 2048 + ch * 2; *(f32x4*)a = (f32x4){l0, h0, l1, h1};
    }
}
__device__ __forceinline__ void phase_lru_final(const Params& p) {
    bf16_t* proj = (bf16_t*)(p.ws + A_PROJ); const float* agg = (const float*)(p.ws + A_ST);
    const int ch = TID() * 2;
    for (int u = BID(); u < 512; u += GDIM()) {
        const int t0 = u * 64, c = u & 127, ub = u - c; float h0 = 0.f, h1 = 0.f;
        int j = 0;
#pragma unroll 1
        for (; j + 8 <= c; j += 8) { f32x4 a[8];
#pragma unroll
            for (int i = 0; i < 8; ++i) a[i] = *(const f32x4*)(agg + (size_t)(ub + j + i) * 2048 + ch * 2);
#pragma unroll
            for (int i = 0; i < 8; ++i) { h0 = __expf(a[i][0]) * h0 + a[i][1]; h1 = __expf(a[i][2]) * h1 + a[i][3]; } }
        for (; j < c; ++j) { const f32x4 a = *(const f32x4*)(agg + (size_t)(ub + j) * 2048 + ch * 2); h0 = __expf(a[0]) * h0 + a[1]; h1 = __expf(a[2]) * h1 + a[3]; }
#pragma unroll 1
        for (int lb = 0; lb < 64; lb += 8) { unsigned la[8], uu[8], gt[8];
#pragma unroll
            for (int i = 0; i < 8; ++i) { const bf16_t* row = proj + (size_t)(t0 + lb + i) * PROJ_LD; la[i] = *(const unsigned*)(row + 3072 + ch); uu[i] = *(const unsigned*)(row + 2048 + ch); gt[i] = *(const unsigned*)(row + ch); }
#pragma unroll
            for (int i = 0; i < 8; ++i) { h0 = __expf(__uint_as_float(la[i] << 16)) * h0 + __uint_as_float(uu[i] << 16); h1 = __expf(__uint_as_float(la[i] & 0xffff0000u)) * h1 + __uint_as_float(uu[i] & 0xffff0000u);
                *(unsigned*)(proj + (size_t)(t0 + lb + i) * PROJ_LD + ch) = pk2(h0 * gelu_tanh(__uint_as_float(gt[i] << 16)), h1 * gelu_tanh(__uint_as_float(gt[i] & 0xffff0000u))); } }
    }
}
__device__ __forceinline__ void phase_ssd_rec(const Params& p) {
    bf16_t* st = (bf16_t*)(p.ws + A_ST); const float* chtot = (const float*)(p.ws + S_CHTOT);
    for (int idx = BID() * 512 + TID(); idx < 131072; idx += GDIM() * 512) {
        const int n4 = idx & 31, pp = (idx >> 5) & 63, hh = (idx >> 11) & 15, b = idx >> 15;
        float r0 = 0.f, r1 = 0.f, r2 = 0.f, r3 = 0.f;
        bf16_t* base = st + ((size_t)(b * 64 * 16 + hh) * 64 + pp) * 128 + n4 * 4; const size_t cstride = (size_t)16 * 64 * 128;
#pragma unroll 1
        for (int c0 = 0; c0 < 64; c0 += 8) { u32x2 sv[8]; float dv[8];
#pragma unroll
            for (int i = 0; i < 8; ++i) { sv[i] = *(const u32x2*)(base + (size_t)(c0 + i) * cstride); dv[i] = chtot[(b * 64 + c0 + i) * 16 + hh]; }
#pragma unroll
            for (int i = 0; i < 8; ++i) { const float d = __expf(dv[i]);
                u32x2 w; w.x = pk2(r0, r1); w.y = pk2(r2, r3); *(u32x2*)(base + (size_t)(c0 + i) * cstride) = w;
                r0 = r0 * d + __uint_as_float(sv[i].x << 16); r1 = r1 * d + __uint_as_float(sv[i].x & 0xffff0000u); r2 = r2 * d + __uint_as_float(sv[i].y << 16); r3 = r3 * d + __uint_as_float(sv[i].y & 0xffff0000u); } }
    }
}
#define MFMA16(x, y, acc) __builtin_amdgcn_mfma_f32_16x16x32_bf16((x), (y), (acc), 0, 0, 0)
__device__ __forceinline__ bf16_t bf1(float v) { return (bf16_t)(pk2(v, 0.f) & 0xffffu); }
__device__ __forceinline__ void ssd_dt_scan(const Params& p, int b, int c, int g, float* dtv, float* acs, bool write_tot) {
    const int w = TID() >> 6, lane = TID() & 63, hh = g * 8 + w;
    const float a = -__expf(p.in[20][hh]), bias = p.in[19][hh]; const float* dt = (const float*)(p.ws + A_DT);
    const size_t t0 = (size_t)b * SEQL + c * 128;
    const float d0 = softplusf(dt[(t0 + lane) * 16 + hh] + bias), d1 = softplusf(dt[(t0 + 64 + lane) * 16 + hh] + bias);
    float v0 = d0 * a, v1 = d1 * a;
#pragma unroll
    for (int o = 1; o < 64; o <<= 1) { const float t0v = __shfl_up(v0, o), t1v = __shfl_up(v1, o); if (lane >= o) { v0 += t0v; v1 += t1v; } }
    v1 += __shfl(v0, 63);
    dtv[w * 128 + lane] = d0; dtv[w * 128 + 64 + lane] = d1; acs[w * 128 + lane] = v0; acs[w * 128 + 64 + lane] = v1;
    if (write_tot && lane == 63) ((float*)(p.ws + S_CHTOT))[(b * 64 + c) * 16 + hh] = v1;
}
__device__ __forceinline__ void ssd_pass1_unit(const Params& p, int unit, unsigned char* sm) {
    const int g = unit & 1, c = (unit >> 1) & 63, b = unit >> 7;
    bf16_t* BT = (bf16_t*)sm; bf16_t* xT = (bf16_t*)(sm + 34816); float* dtv = (float*)(sm + 52224); float* acs = (float*)(sm + 56320);
    const int tid = TID(), w = tid >> 6, lane = tid & 63, fr = lane & 15, fq = lane >> 4;
    const bf16_t* proj = (const bf16_t*)(p.ws + A_PROJ); bf16_t* st = (bf16_t*)(p.ws + A_ST);
    const size_t t0 = (size_t)b * SEQL + c * 128; const int tl0 = c * 128;
    const float* cw = p.in[17]; const float* cbi = p.in[18];
    ssd_dt_scan(p, b, c, g, dtv, acs, true);
#pragma unroll 1
    for (int i = 0; i < 4; ++i) { const int l = (tid >> 4) + 32 * i, oct = tid & 15, ch = 1024 + g * 128 + oct * 8; float o[8];
        conv8(proj + (t0 + l) * PROJ_LD + 3072 + ch, PROJ_LD, tl0 + l, cw + ch, 1536, cbi + ch, o);
#pragma unroll
        for (int e = 0; e < 8; ++e) BT[(oct * 8 + e) * 136 + l] = bf1(siluf(o[e])); }
    __syncthreads();
    const int xl = tid >> 3, xo = tid & 7;
    u32x4 xr[2][4];
#pragma unroll
    for (int i = 0; i < 2; ++i) conv8_load(proj + (t0 + xl + 64 * i) * PROJ_LD + 3072 + g * 512 + xo * 8, PROJ_LD, tl0 + xl + 64 * i, xr[i]);
#pragma unroll 1
    for (int hi = 0; hi < 8; ++hi) { const int hh = g * 8 + hi;
#pragma unroll
        for (int i = 0; i < 2; ++i) { const int l = xl + 64 * i, ch = hh * 64 + xo * 8; float o[8];
            conv8_calc(xr[i], cw + ch, 1536, cbi + ch, o);
            const float sc = dtv[hi * 128 + l] * __expf(acs[hi * 128 + 127] - acs[hi * 128 + l]);
#pragma unroll
            for (int e = 0; e < 8; ++e) xT[(xo * 8 + e) * 136 + l] = bf1(siluf(o[e]) * sc); }
        __syncthreads();
        if (hi < 7) {
#pragma unroll
            for (int i = 0; i < 2; ++i) conv8_load(proj + (t0 + xl + 64 * i) * PROJ_LD + 3072 + (hh + 1) * 64 + xo * 8, PROJ_LD, tl0 + xl + 64 * i, xr[i]); }
        const int pt = w & 3, nt0 = (w >> 2) * 4;
        f32x4 acc[4];
#pragma unroll
        for (int q = 0; q < 4; ++q) acc[q] = (f32x4){0.f, 0.f, 0.f, 0.f};
#pragma unroll
        for (int ks = 0; ks < 4; ++ks) { const bf16x8 y = *(const bf16x8*)(xT + (16 * pt + fr) * 136 + ks * 32 + fq * 8);
#pragma unroll
            for (int q = 0; q < 4; ++q) { const bf16x8 x = *(const bf16x8*)(BT + (16 * (nt0 + q) + fr) * 136 + ks * 32 + fq * 8); acc[q] = MFMA16(x, y, acc[q]); } }
        bf16_t* so = st + ((size_t)((b * 64 + c) * 16 + hh) * 64 + 16 * pt + fr) * 128;
#pragma unroll
        for (int q = 0; q < 4; ++q) { u32x2 wv; wv.x = pk2(acc[q][0], acc[q][1]); wv.y = pk2(acc[q][2], acc[q][3]); *(u32x2*)(so + 16 * (nt0 + q) + 4 * fq) = wv; }
        __syncthreads();
    }
}
__device__ __forceinline__ void ssd_pass3_unit(const Params& p, int unit, unsigned char* sm) {
    const int g = unit & 1, c = (unit >> 1) & 63, b = unit >> 7;
    const int tid = TID(), w = tid >> 6, lane = tid & 63, fr = lane & 15, fq = lane >> 4;
    bf16_t* Cs = (bf16_t*)sm; bf16_t* Bs = (bf16_t*)(sm + 34816); bf16_t* xT0 = (bf16_t*)(sm + 69632); bf16_t* Pw = (bf16_t*)(sm + 104448 + w * 4352);
    float* dtv = (float*)(sm + 139264); float* acs = (float*)(sm + 143360);
    bf16_t* proj = (bf16_t*)(p.ws + A_PROJ); const bf16_t* st = (const bf16_t*)(p.ws + A_ST);
    const size_t t0 = (size_t)b * SEQL + c * 128; const int tl0 = c * 128;
    const float* cw = p.in[17]; const float* cbi = p.in[18];
    ssd_dt_scan(p, b, c, g, dtv, acs, false);
#pragma unroll 1
    for (int i = 0; i < 8; ++i) { const int item = tid + 512 * i, arr = item >> 11, l = (item >> 4) & 127, oct = item & 15, ch = 1024 + arr * 256 + g * 128 + oct * 8; float o[8];
        conv8(proj + (t0 + l) * PROJ_LD + 3072 + ch, PROJ_LD, tl0 + l, cw + ch, 1536, cbi + ch, o);
#pragma unroll
        for (int e = 0; e < 8; ++e) o[e] = siluf(o[e]);
        *(u32x4*)((arr ? Cs : Bs) + l * 136 + oct * 8) = PACK8(o); }
    __syncthreads();
    const int l0 = 16 * w, l = l0 + fr; const size_t trow = t0 + l;
    bf16x8 cf[4];
#pragma unroll
    for (int ks = 0; ks < 4; ++ks) cf[ks] = *(const bf16x8*)(Cs + (l0 + fr) * 136 + ks * 32 + fq * 8);
    f32x4 cb[8];
#pragma unroll
    for (int nt = 0; nt < 8; ++nt) { cb[nt] = (f32x4){0.f, 0.f, 0.f, 0.f};
#pragma unroll
        for (int ks = 0; ks < 4; ++ks) { const bf16x8 x = *(const bf16x8*)(Bs + (16 * nt + fr) * 136 + ks * 32 + fq * 8); cb[nt] = MFMA16(x, cf[ks], cb[nt]); } }
    float ss = 0.f;
    const int xl = tid >> 3, xo = tid & 7;
    u32x4 xr[2][4];
#pragma unroll
    for (int i = 0; i < 2; ++i) conv8_load(proj + (t0 + xl + 64 * i) * PROJ_LD + 3072 + g * 512 + xo * 8, PROJ_LD, tl0 + xl + 64 * i, xr[i]);
#pragma unroll 1
    for (int hi = 0; hi < 8; ++hi) { const int hh = g * 8 + hi; bf16_t* xT = xT0 + (hi & 1) * 8704;
        const bf16_t* prev = st + (size_t)((b * 64 + c) * 16 + hh) * 64 * 128;
        bf16x8 pf[4][4]; u32x2 zr[4];
#pragma unroll
        for (int ks = 0; ks < 4; ++ks)
#pragma unroll
            for (int pt = 0; pt < 4; ++pt) pf[ks][pt] = *(const bf16x8*)(prev + (size_t)(16 * pt + fr) * 128 + ks * 32 + fq * 8);
#pragma unroll
        for (int pt = 0; pt < 4; ++pt) zr[pt] = *(const u32x2*)(proj + trow * PROJ_LD + 1024 + hh * 64 + 16 * pt + 4 * fq);
#pragma unroll
        for (int i = 0; i < 2; ++i) { const int l_ = xl + 64 * i, ch = hh * 64 + xo * 8; float o[8];
            conv8_calc(xr[i], cw + ch, 1536, cbi + ch, o);
#pragma unroll
            for (int e = 0; e < 8; ++e) xT[(xo * 8 + e) * 136 + l_] = bf1(siluf(o[e])); }
        const float al = acs[hi * 128 + l];
#pragma unroll
        for (int nt = 0; nt < 8; ++nt) { float v[4]; const f32x4 a4 = *(const f32x4*)(acs + hi * 128 + 16 * nt + 4 * fq), d4 = *(const f32x4*)(dtv + hi * 128 + 16 * nt + 4 * fq);
#pragma unroll
            for (int j = 0; j < 4; ++j) { const int s = 16 * nt + 4 * fq + j; v[j] = (s <= l) ? cb[nt][j] * __expf(al - a4[j]) * d4[j] : 0.f; }
            u32x2 wv; wv.x = pk2(v[0], v[1]); wv.y = pk2(v[2], v[3]); *(u32x2*)(Pw + fr * 136 + 16 * nt + 4 * fq) = wv; }
        __syncthreads();
        if (hi < 7) {
#pragma unroll
            for (int i = 0; i < 2; ++i) conv8_load(proj + (t0 + xl + 64 * i) * PROJ_LD + 3072 + (hh + 1) * 64 + xo * 8, PROJ_LD, tl0 + xl + 64 * i, xr[i]); }
        f32x4 yd[4], yo[4];
#pragma unroll
        for (int pt = 0; pt < 4; ++pt) { yd[pt] = (f32x4){0.f, 0.f, 0.f, 0.f}; yo[pt] = (f32x4){0.f, 0.f, 0.f, 0.f}; }
#pragma unroll
        for (int ks = 0; ks < 4; ++ks) { const bf16x8 yf = *(const bf16x8*)(Pw + fr * 136 + ks * 32 + fq * 8);
#pragma unroll
            for (int pt = 0; pt < 4; ++pt) { const bf16x8 x = *(const bf16x8*)(xT + (16 * pt + fr) * 136 + ks * 32 + fq * 8); yd[pt] = MFMA16(x, yf, yd[pt]);
                yo[pt] = MFMA16(pf[ks][pt], cf[ks], yo[pt]); } }
        const float ea = __expf(al), Dh = p.in[21][hh];
#pragma unroll
        for (int pt = 0; pt < 4; ++pt) { const int pp = 16 * pt + 4 * fq; bf16_t* za = proj + trow * PROJ_LD + 1024 + hh * 64 + pp;
            float zv[4] = {__uint_as_float(zr[pt].x << 16), __uint_as_float(zr[pt].x & 0xffff0000u), __uint_as_float(zr[pt].y << 16), __uint_as_float(zr[pt].y & 0xffff0000u)}; float y[4];
#pragma unroll
            for (int j = 0; j < 4; ++j) { const float xv = bf2f(xT[(pp + j) * 136 + l]); y[j] = (yd[pt][j] + ea * yo[pt][j] + Dh * xv) * siluf(zv[j]); ss += y[j] * y[j]; }
            u32x2 wv; wv.x = pk2(y[0], y[1]); wv.y = pk2(y[2], y[3]); *(u32x2*)za = wv; }
    }
    ss += __shfl_xor(ss, 16); ss += __shfl_xor(ss, 32);
    { const float rs = rsqrtf(ss * (1.0f / 512.0f) + 1e-6f); const float* gn = p.in[22] + g * 512 + 4 * fq;
#pragma unroll 2
      for (int it = 0; it < 32; ++it) { const int hi = it >> 2, pt = it & 3; bf16_t* za = proj + trow * PROJ_LD + 1024 + (g * 8 + hi) * 64 + 16 * pt + 4 * fq;
          const u32x2 r = *(const u32x2*)za; const f32x4 g4 = *(const f32x4*)(gn + hi * 64 + 16 * pt);
          u32x2 wv; wv.x = pk2(__uint_as_float(r.x << 16) * rs * g4[0], __uint_as_float(r.x & 0xffff0000u) * rs * g4[1]);
          wv.y = pk2(__uint_as_float(r.y << 16) * rs * g4[2], __uint_as_float(r.y & 0xffff0000u) * rs * g4[3]); *(u32x2*)za = wv; } }
    __syncthreads();
}
__device__ __forceinline__ void phase_ml_conv(const Params& p) {
    const bf16_t* up = (const bf16_t*)(p.ws + A_PROJ); bf16_t* xc = (bf16_t*)(p.ws + A_XC); float* gp = (float*)(p.ws + A_GP); const float* weff = (const float*)(p.ws + S_WEFF);
    const int tid = TID(), oct = tid & 255, sub = tid >> 8, ch = oct * 8, lane = tid & 63, wq4 = (tid >> 6) & 3;
    float cw[4][8], cbv[8]; f32x2 wc[8][4], wm[8][4];
#pragma unroll
    for (int e = 0; e < 8; ++e) { cbv[e] = p.in[25][ch + e];
#pragma unroll
        for (int k = 0; k < 4; ++k) cw[k][e] = p.in[24][k * 2048 + ch + e];
#pragma unroll
        for (int g = 0; g < 4; ++g) { wc[e][g] = *(const f32x2*)(weff + (size_t)(ch + e) * 8 + 2 * g); wm[e][g] = *(const f32x2*)(weff + (size_t)(2048 + ch + e) * 8 + 2 * g); } }
    const int nstream = GDIM() * 2, len = T_TOK / nstream; int t = (BID() * 2 + sub) * len;
    float x0[8], x1[8], x2[8];
    { const int tl = t & (SEQL - 1); u32x4 r;
      if (tl >= 3) { r = *(const u32x4*)(up + (size_t)(t - 3) * 4096 + ch); UNPACK8(r, x0); } else {
#pragma unroll
          for (int e = 0; e < 8; ++e) x0[e] = 0.f; }
      if (tl >= 2) { r = *(const u32x4*)(up + (size_t)(t - 2) * 4096 + ch); UNPACK8(r, x1); } else {
#pragma unroll
          for (int e = 0; e < 8; ++e) x1[e] = 0.f; }
      if (tl >= 1) { r = *(const u32x4*)(up + (size_t)(t - 1) * 4096 + ch); UNPACK8(r, x2); } else {
#pragma unroll
          for (int e = 0; e < 8; ++e) x2[e] = 0.f; } }
    u32x4 nxt = *(const u32x4*)(up + (size_t)t * 4096 + ch);
    const bool lo32 = lane < 32, b16 = ((lane >> 4) & 1) == 0, b8 = ((lane >> 3) & 1) == 0;
    const int gidx = (lo32 ? 0 : 4) + (b16 ? 0 : 2) + (b8 ? 0 : 1);
#pragma unroll 1
    for (int i = 0; i < len; ++i, ++t) {
        if (i > 0 && (t & (SEQL - 1)) == 0) {
#pragma unroll
            for (int e = 0; e < 8; ++e) { x0[e] = 0.f; x1[e] = 0.f; x2[e] = 0.f; } }
        const u32x4 cur = nxt; if (i + 1 < len) nxt = *(const u32x4*)(up + (size_t)(t + 1) * 4096 + ch);
        float xm[8], o[8]; UNPACK8(cur, xm);
#pragma unroll
        for (int e = 0; e < 8; ++e) o[e] = siluf(cbv[e] + cw[0][e] * x0[e] + cw[1][e] * x1[e] + cw[2][e] * x2[e] + cw[3][e] * xm[e]);
        *(u32x4*)(xc + (size_t)t * 2048 + ch) = PACK8(o);
        float gs[8];
#pragma unroll
        for (int g = 0; g < 4; ++g) { f32x2 a = (f32x2){0.f, 0.f};
#pragma unroll
            for (int e = 0; e < 8; ++e) { a += wc[e][g] * o[e]; a += wm[e][g] * xm[e]; }
            gs[2 * g] = a.x; gs[2 * g + 1] = a.y; }
        float k4[4], k2[2], k1;
#pragma unroll
        for (int q = 0; q < 4; ++q) { const float snd = lo32 ? gs[4 + q] : gs[q]; const float rcv = __shfl_xor(snd, 32); k4[q] = (lo32 ? gs[q] : gs[4 + q]) + rcv; }
#pragma unroll
        for (int q = 0; q < 2; ++q) { const float snd = b16 ? k4[2 + q] : k4[q]; const float rcv = __shfl_xor(snd, 16); k2[q] = (b16 ? k4[q] : k4[2 + q]) + rcv; }
        { const float snd = b8 ? k2[1] : k2[0]; const float rcv = __shfl_xor(snd, 8); k1 = (b8 ? k2[0] : k2[1]) + rcv; }
        k1 += __shfl_xor(k1, 4); k1 += __shfl_xor(k1, 2); k1 += __shfl_xor(k1, 1);
        if ((lane & 7) == 0) gp[((size_t)t * 4 + wq4) * 8 + gidx] = k1;
#pragma unroll
        for (int e = 0; e < 8; ++e) { x0[e] = x1[e]; x1[e] = x2[e]; x2[e] = xm[e]; }
    }
}
__device__ __forceinline__ bf16x8 bd8(const u32x4 r, const float* wl, int blk0) {
    float v[8], q[8]; UNPACK8(r, v);
#pragma unroll
    for (int bb = 0; bb < 2; ++bb) { const float* wb = wl + (blk0 + bb) * 16;
        const f32x4 w0 = *(const f32x4*)(wb), w1 = *(const f32x4*)(wb + 4), w2 = *(const f32x4*)(wb + 8), w3 = *(const f32x4*)(wb + 12);
#pragma unroll
        for (int o = 0; o < 4; ++o) q[4 * bb + o] = v[4 * bb] * w0[o] + v[4 * bb + 1] * w1[o] + v[4 * bb + 2] * w2[o] + v[4 * bb + 3] * w3[o]; }
    const u32x4 pk = PACK8(q); return __builtin_bit_cast(bf16x8, pk);
}
__device__ __forceinline__ void phase_ml_intra(const Params& p, unsigned char* sm) {
    const int tid = TID(), w = tid >> 6, lane = tid & 63, fr = lane & 15, fq = lane >> 4;
    bf16_t* ksm = (bf16_t*)sm; float* wql = (float*)(sm + 66560); float* wkl = (float*)(sm + 74752); float* bc = (float*)(sm + 82944); float* ig = (float*)(sm + 83200); float* rs = (float*)(sm + 83456);
    const bf16_t* xc = (const bf16_t*)(p.ws + A_XC); const float* gp = (const float*)(p.ws + A_GP);
    int curh = -1;
    const int ks_s = tid >> 3, ks_o = tid & 7;
    u32x4 kr[8];
    { const int it0 = BID(); if (it0 < 2048) { const int h0 = it0 & 3, j0 = it0 >> 2; const size_t tt0 = (size_t)(j0 >> 7) * SEQL + (j0 & 127) * 64;
        const bf16_t* src = xc + (tt0 + ks_s) * 2048 + h0 * 512 + ks_o * 8;
#pragma unroll
        for (int i = 0; i < 8; ++i) kr[i] = *(const u32x4*)(src + i * 64); } }
    for (int it = BID(); it < 2048; it += GDIM()) {
        const int h = it & 3, j = it >> 2, bq = j >> 7, c = j & 127, unit = (bq * 4 + h) * 128 + c;
        float* aux = (float*)(p.ws + A_AUX) + (size_t)unit * 256; bf16_t* si = (bf16_t*)(p.ws + A_SI) + (size_t)unit * 4096;
        const size_t t0 = (size_t)bq * SEQL + c * 64;
        if (h != curh) { __syncthreads(); const float* gq = (const float*)(p.ws + S_GQK) + h * 2048;
            for (int i = tid; i < 2048; i += 512) { const int blk = i >> 4, ii = (i >> 2) & 3, oo = i & 3; wkl[i] = gq[blk * 16 + oo * 4 + ii]; } curh = h; __syncthreads(); }
#pragma unroll
        for (int i = 0; i < 8; ++i) *(bf16x8*)(ksm + ks_s * 520 + (ks_o + 8 * i) * 8) = bd8(kr[i], wkl, (ks_o + 8 * i) * 2);
        if (w == 0) { const float* g0 = gp + (t0 + lane) * 32; float ip = p.in[30][h], fp = p.in[30][4 + h];
#pragma unroll
            for (int q = 0; q < 4; ++q) { ip += g0[q * 8 + h]; fp += g0[q * 8 + 4 + h]; }
            float v = -softplusf(-fp);
#pragma unroll
            for (int o = 1; o < 64; o <<= 1) { const float tv = __shfl_up(v, o); if (lane >= o) v += tv; }
            const float bl = __shfl(v, 63);
            bc[lane] = v; ig[lane] = ip; aux[lane] = __expf(v); aux[64 + lane] = __expf(bl - v + ip); if (lane == 0) aux[192] = __expf(bl); }
        __syncthreads();
        { const int itn = it + GDIM(); if (itn < 2048) { const int hn = itn & 3, jn = itn >> 2; const size_t ttn = (size_t)(jn >> 7) * SEQL + (jn & 127) * 64;
            const bf16_t* src = xc + (ttn + ks_s) * 2048 + hn * 512 + ks_o * 8;
#pragma unroll
            for (int i = 0; i < 8; ++i) kr[i] = *(const u32x4*)(src + i * 64); } }
        const int mt = w >> 1, nt0 = (w & 1) * 2;
        f32x4 acc[2]; acc[0] = (f32x4){0.f, 0.f, 0.f, 0.f}; acc[1] = acc[0];
        if (nt0 <= mt) {
            const bf16_t* xq = xc + (t0 + 16 * mt + fr) * 2048 + h * 512 + fq * 8;
            u32x4 qr[16];
#pragma unroll
            for (int ks = 0; ks < 16; ++ks) qr[ks] = *(const u32x4*)(xq + ks * 32);
#pragma unroll
            for (int ks = 0; ks < 16; ++ks) { const bf16x8 yq = __builtin_bit_cast(bf16x8, qr[ks]);
                const bf16x8 k0 = *(const bf16x8*)(ksm + (16 * nt0 + fr) * 520 + ks * 32 + fq * 8), k1 = *(const bf16x8*)(ksm + (16 * nt0 + 16 + fr) * 520 + ks * 32 + fq * 8);
                acc[0] = MFMA16(k0, yq, acc[0]); acc[1] = MFMA16(k1, yq, acc[1]); } }
        const int t = 16 * mt + fr; const float bt = bc[t]; float rsum = 0.f;
#pragma unroll
        for (int q = 0; q < 2; ++q) { float v[4];
#pragma unroll
            for (int jj = 0; jj < 4; ++jj) { const int s = 16 * (nt0 + q) + 4 * fq + jj; v[jj] = (s <= t) ? acc[q][jj] * __expf(bt - bc[s] + ig[s]) : 0.f; rsum += v[jj]; }
            u32x2 wv; wv.x = pk2(v[0], v[1]); wv.y = pk2(v[2], v[3]); *(u32x2*)(si + t * 64 + 16 * (nt0 + q) + 4 * fq) = wv; }
        rsum += __shfl_xor(rsum, 16); rsum += __shfl_xor(rsum, 32);
        if (fq == 0) rs[(w & 1) * 64 + t] = rsum;
        __syncthreads();
        if (tid < 64) aux[128 + tid] = rs[tid] + rs[64 + tid];
        __syncthreads();
    }
}
typedef short s16x4 __attribute__((ext_vector_type(4)));
__device__ __forceinline__ bf16x8 tr_frag(LAS unsigned char* a) {
    const s16x4 lo = __builtin_amdgcn_ds_read_tr16_b64_v4i16((LAS s16x4*)a), hi = __builtin_amdgcn_ds_read_tr16_b64_v4i16((LAS s16x4*)(a + 4 * 1040));
    return (bf16x8){lo[0], lo[1], lo[2], lo[3], hi[0], hi[1], hi[2], hi[3]};
}
__device__ __forceinline__ void ml_seq_item(const Params& p, int item, unsigned char* sm, LAS unsigned char* lds) {
    const int bh = (item & 7) * 2 + ((item >> 3) & 1), slice = item >> 4, h = bh & 3, b = bh >> 2, vcol0 = h * 512 + slice * 32;
    const int tid = TID(), w = tid >> 6, lane = tid & 63, fr = lane & 15, fq = lane >> 4;
    bf16_t* xcN = (bf16_t*)sm; bf16_t* MT0 = (bf16_t*)(sm + 66560); bf16_t* nrow0 = (bf16_t*)(sm + 133120); bf16_t* vT = (bf16_t*)(sm + 135296); bf16_t* vwT = (bf16_t*)(sm + 139904);
    float* G = (float*)(sm + 144512); float* scl = (float*)(sm + 152704); bf16_t* wsb = (bf16_t*)(sm + 153728);
    const bf16_t* xc = (const bf16_t*)(p.ws + A_XC); bf16_t* up = (bf16_t*)(p.ws + A_PROJ); const float* auxb = (const float*)(p.ws + A_AUX); const bf16_t* sib = (const bf16_t*)(p.ws + A_SI);
    for (int i = tid; i < 32 * 520; i += 512) ((unsigned*)MT0)[i] = 0u;
    for (int i = tid; i < 544; i += 512) ((unsigned*)nrow0)[i] = 0u;
    for (int i = tid; i < 2048; i += 512) G[i] = ((const float*)(p.ws + S_GQK))[h * 2048 + i];
    f32x4 M[4][2], N[4];
#pragma unroll
    for (int q = 0; q < 4; ++q) { M[q][0] = (f32x4){0.f, 0.f, 0.f, 0.f}; M[q][1] = M[q][0]; N[q] = M[q][0]; }
    float* wvl = (float*)(sm + 153984);
    if (tid < 128) wvl[tid] = p.in[28][(size_t)(vcol0 >> 2) * 16 + tid];
    const int vs = tid >> 3, vb = tid & 7;
    const int trB = 32 * (w & 1) + fr, vtB = (w >> 1) & 1;
    LAS unsigned char* trbase = lds + (size_t)((fq * 8 + (fr >> 2)) * 520 + 4 * (fr & 3)) * 2;
    u32x4 stg[8]; u32x4 sreg; u32x2 vraw; float auxv, wsv;
    bf16_t* ssm = (bf16_t*)(sm + 154496);
#define ML_ISSUE(cc) do { const int unit_ = bh * 128 + (cc); const size_t t0_ = (size_t)b * SEQL + (size_t)(cc) * 64; const float* aux_ = auxb + (size_t)unit_ * 256; \
        auxv = aux_[tid & 255]; wsv = aux_[64 + vs]; \
        { const bf16_t* s_ = xc + (t0_ + vs) * 2048 + h * 512 + vb * 8; _Pragma("unroll") for (int i_ = 0; i_ < 8; ++i_) stg[i_] = *(const u32x4*)(s_ + i_ * 64); } \
        vraw = *(const u32x2*)(up + (t0_ + vs) * 4096 + vcol0 + 4 * vb); \
        sreg = *(const u32x4*)(sib + (size_t)unit_ * 4096 + tid * 8); \
        } while (0)
#define LBAR() do { asm volatile("s_waitcnt lgkmcnt(0)" ::: "memory"); __builtin_amdgcn_s_barrier(); asm volatile("" ::: "memory"); } while (0)
    ML_ISSUE(0);
    __syncthreads();
    bf16x8 Xg[4];
#pragma unroll
    for (int q = 0; q < 4; ++q) { const float* Gb = G + (4 * (4 * w + q) + (fr >> 2)) * 16 + (fr & 3) * 4; const bool on = (fq == (fr >> 2));
        const unsigned p0 = on ? pk2(Gb[0], Gb[1]) : 0u, p1 = on ? pk2(Gb[2], Gb[3]) : 0u; const u32x4 pk = (u32x4){p0, p1, 0u, 0u}; Xg[q] = __builtin_bit_cast(bf16x8, pk); }
#pragma unroll 1
    for (int c = 0; c < 128; ++c) {
        const size_t t0 = (size_t)b * SEQL + c * 64;
        bf16_t* MTc = MT0 + (c & 1) * (32 * 520); bf16_t* MTn = MT0 + ((c + 1) & 1) * (32 * 520); bf16_t* nrc = nrow0 + (c & 1) * 544; bf16_t* nrn = nrow0 + ((c + 1) & 1) * 544;
        if (tid < 256) scl[tid] = auxv;
        if (tid >= 64 && tid < 128) wsb[tid - 64] = bf1(auxv);
        *(u32x4*)(ssm + vs * 72 + vb * 8) = sreg;
#pragma unroll
        for (int i = 0; i < 8; ++i) *(u32x4*)(xcN + vs * 520 + (vb + 8 * i) * 8) = stg[i];
        { const float x0 = __uint_as_float(vraw.x << 16), x1 = __uint_as_float(vraw.x & 0xffff0000u), x2 = __uint_as_float(vraw.y << 16), x3 = __uint_as_float(vraw.y & 0xffff0000u);
          const f32x4 w0 = *(const f32x4*)(wvl + vb * 16), w1 = *(const f32x4*)(wvl + vb * 16 + 4), w2 = *(const f32x4*)(wvl + vb * 16 + 8), w3 = *(const f32x4*)(wvl + vb * 16 + 12);
#pragma unroll
          for (int o = 0; o < 4; ++o) { const float v = x0 * w0[o] + x1 * w1[o] + x2 * w2[o] + x3 * w3[o]; vT[(4 * vb + o) * 72 + vs] = bf1(v); vwT[(4 * vb + o) * 72 + vs] = bf1(v * wsv); } }
        LBAR();
        if (c + 1 < 128) ML_ISSUE(c + 1);
        if (w < 4) {
          f32x4 ai[2], aa[2], aq[2];
#pragma unroll
          for (int a = 0; a < 2; ++a) { aq[a] = (f32x4){0.f, 0.f, 0.f, 0.f}; ai[a] = aq[a]; aa[a] = aq[a]; }
#pragma unroll 2
          for (int ks = 0; ks < 16; ++ks) { const bf16x8 y0 = *(const bf16x8*)(xcN + trB * 520 + ks * 32 + fq * 8), y1 = *(const bf16x8*)(xcN + (trB + 16) * 520 + ks * 32 + fq * 8);
              const bf16x8 x = *(const bf16x8*)(MTc + (16 * vtB + fr) * 520 + ks * 32 + fq * 8);
              bf16x8 xn = (bf16x8){0, 0, 0, 0, 0, 0, 0, 0}; if (fr == 0) xn = *(const bf16x8*)(nrc + ks * 32 + fq * 8);
              ai[0] = MFMA16(x, y0, ai[0]); ai[1] = MFMA16(x, y1, ai[1]); aq[0] = MFMA16(xn, y0, aq[0]); aq[1] = MFMA16(xn, y1, aq[1]); }
#pragma unroll
          for (int ks = 0; ks < 2; ++ks) { const bf16x8 xv = *(const bf16x8*)(vT + (16 * vtB + fr) * 72 + ks * 32 + fq * 8);
              const bf16x8 s0 = *(const bf16x8*)(ssm + trB * 72 + ks * 32 + fq * 8), s1 = *(const bf16x8*)(ssm + (trB + 16) * 72 + ks * 32 + fq * 8);
              aa[0] = MFMA16(xv, s0, aa[0]); aa[1] = MFMA16(xv, s1, aa[1]); }
#pragma unroll
          for (int a = 0; a < 2; ++a) { const int tr = trB + 16 * a; const float qn = __shfl(aq[a][0], fr); const float eb = scl[tr];
              const float inv = __builtin_amdgcn_rcpf(fmaxf(fabsf(scl[128 + tr] + eb * qn), 1.0f));
              u32x2 wv; wv.x = pk2((aa[a][0] + eb * ai[a][0]) * inv, (aa[a][1] + eb * ai[a][1]) * inv); wv.y = pk2((aa[a][2] + eb * ai[a][2]) * inv, (aa[a][3] + eb * ai[a][3]) * inv);
              *(u32x2*)(up + (t0 + tr) * 4096 + vcol0 + 16 * vtB + 4 * fq) = wv; }
        }
        {
          const float decay = scl[192];
#pragma unroll
          for (int q = 0; q < 4; ++q) { M[q][0] *= decay; M[q][1] *= decay; N[q] *= decay; }
#pragma unroll
          for (int ks = 0; ks < 2; ++ks) { const bf16x8 y0 = *(const bf16x8*)(vwT + fr * 72 + ks * 32 + fq * 8), y1 = *(const bf16x8*)(vwT + (16 + fr) * 72 + ks * 32 + fq * 8);
              bf16x8 y2 = (bf16x8){0, 0, 0, 0, 0, 0, 0, 0}; if (fr == 0) y2 = *(const bf16x8*)(wsb + ks * 32 + fq * 8);
#pragma unroll
              for (int q = 0; q < 4; ++q) { const bf16x8 x = tr_frag(trbase + (size_t)(ks * 32 * 520 + 16 * (4 * w + q)) * 2);
                  M[q][0] = MFMA16(x, y0, M[q][0]); M[q][1] = MFMA16(x, y1, M[q][1]); N[q] = MFMA16(x, y2, N[q]); } }
#pragma unroll
          for (int q = 0; q < 4; ++q) {
#pragma unroll
              for (int v2 = 0; v2 < 3; ++v2) { const f32x4 m = (v2 == 2) ? N[q] : M[q][v2 & 1];
                  const u32x4 yk = (u32x4){pk2(m[0], m[1]), pk2(m[2], m[3]), 0u, 0u};
                  const f32x4 mt = MFMA16(Xg[q], __builtin_bit_cast(bf16x8, yk), ((f32x4){0.f, 0.f, 0.f, 0.f}));
                  u32x2 wv; wv.x = pk2(mt[0], mt[1]); wv.y = pk2(mt[2], mt[3]);
                  if (v2 < 2) *(u32x2*)(MTn + (16 * v2 + fr) * 520 + 16 * (4 * w + q) + 4 * fq) = wv;
                  else if (fr == 0) *(u32x2*)(nrn + 16 * (4 * w + q) + 4 * fq) = wv; } }
        }
        LBAR();
    }
    __syncthreads();
#undef ML_ISSUE
#undef LBAR
}
__device__ __forceinline__ void phase_ml_post(const Params& p) {
    bf16_t* up = (bf16_t*)(p.ws + A_PROJ); const bf16_t* xc = (const bf16_t*)(p.ws + A_XC);
    const int lane = TID() & 63, wg = BID() * 8 + (TID() >> 6), nw = GDIM() * 8;
    for (int t = wg; t < T_TOK; t += nw) {
        u32x4 hr[4], zr[4], xr[4];
#pragma unroll
        for (int hh = 0; hh < 4; ++hh) { const int ch = hh * 512 + lane * 8; hr[hh] = *(const u32x4*)(up + (size_t)t * 4096 + ch); zr[hh] = *(const u32x4*)(up + (size_t)t * 4096 + 2048 + ch); xr[hh] = *(const u32x4*)(xc + (size_t)t * 2048 + ch); }
#pragma unroll
        for (int hh = 0; hh < 4; ++hh) { const int ch = hh * 512 + lane * 8;
            float hv[8], zv[8], xv[8], y[8]; UNPACK8(hr[hh], hv); UNPACK8(zr[hh], zv); UNPACK8(xr[hh], xv);
            float s = 0.f;
#pragma unroll
            for (int e = 0; e < 8; ++e) s += hv[e];
#pragma unroll
            for (int o = 32; o >= 1; o >>= 1) s += __shfl_xor(s, o);
            const float mu = s * (1.0f / 512.0f); float q = 0.f;
#pragma unroll
            for (int e = 0; e < 8; ++e) { hv[e] -= mu; q += hv[e] * hv[e]; }
#pragma unroll
            for (int o = 32; o >= 1; o >>= 1) q += __shfl_xor(q, o);
            const float rstd = rsqrtf(q * (1.0f / 512.0f) + 1e-6f);
            const f32x4 g0 = *(const f32x4*)(p.in[31] + ch), g1 = *(const f32x4*)(p.in[31] + ch + 4), k0 = *(const f32x4*)(p.in[32] + ch), k1 = *(const f32x4*)(p.in[32] + ch + 4);
#pragma unroll
            for (int e = 0; e < 4; ++e) { y[e] = (hv[e] * rstd * g0[e] + k0[e] * xv[e]) * siluf(zv[e]); y[4 + e] = (hv[4 + e] * rstd * g1[e] + k1[e] * xv[4 + e]) * siluf(zv[4 + e]); }
            *(u32x4*)(up + (size_t)t * 4096 + 2048 + ch) = PACK8(y); }
    }
}
typedef const __attribute__((address_space(4))) Params* CPar;
#if defined(__HIP_DEVICE_COMPILE__)
__device__ __forceinline__ Params ldp() { CPar q = (CPar)__builtin_amdgcn_kernarg_segment_ptr(); asm volatile("" : "+s"(q)); Params r; for (int i = 0; i < 35; ++i) r.in[i] = q->in[i]; r.out = q->out; r.ws = q->ws; return r; }
#else
__device__ __forceinline__ Params ldp() { return Params{}; }
#endif
__global__ void __launch_bounds__(512) fwd_megakernel(Params p_unused) {
    extern __shared__ __attribute__((aligned(16))) unsigned char shm[];
    cg::grid_group grid = cg::this_grid();
    LAS unsigned char* lds = (LAS unsigned char*)shm;
    unsigned char* sm = shm;
#define GSYNC() do { XcdBarrier b_; b_.bar = (unsigned*)(ldp().ws + S_BAR); b_.x = xb_xcc_id(); b_.st = (volatile LAS unsigned*)(lds + 163776); xcd_barrier(b_); } while (0)
    if (threadIdx.x < 4) ((volatile LAS unsigned*)(lds + 163776))[threadIdx.x] = 0u;
    if (blockIdx.x == 0) { unsigned* bw = (unsigned*)(ldp().ws + S_BAR); for (int i = threadIdx.x; i < XCD_BAR_WORDS; i += 512) bw[i] = 0u; }
    grid.sync();
    xcd_barrier_post((unsigned*)(ldp().ws + S_BAR));
    { const Params p = ldp(); phase_prologue(p, sm); }
    GSYNC();
#pragma unroll 1
    for (int fi = 0; fi < 4; ++fi) {
        const int l = fi >> 1, f = fi & 1, sub = f ? 2 : 0;
        { const Params p = ldp(); const float* modl = (const float*)(p.ws + S_MOD) + (size_t)l * 4 * 9216;
          if (fi == 0) phase_norm(p.in[0], (bf16_t*)(p.ws + A_H), p.in[4] + (l * 3 + sub) * 1024, modl + sub * 3072);
          else phase_norm_b((const bf16_t*)p.out + XB_OFF, (bf16_t*)(p.ws + A_H), p.in[4] + (l * 3 + sub) * 1024, modl + sub * 3072); }
        if (fi == 2) { const Params p = ldp(); phase_cvt_l1(p, sm); }
        GSYNC();
        { const Params p = ldp(); pg8::Gemm g{(const bf16_t*)(p.ws + A_H), (const bf16_t*)(p.ws + (f ? W_GU1 : W_GU0)), T_TOK, 5632, 1024, 1024, 0}; EpiSwiglu e{(bf16_t*)(p.ws + A_PROJ)}; pg8::gemm_phase(lds, g, e); }
        GSYNC();
        { const Params p = ldp(); const float* modl = (const float*)(p.ws + S_MOD) + (size_t)l * 4 * 9216;
          pg8::Gemm g{(const bf16_t*)(p.ws + A_PROJ), (const bf16_t*)(p.ws + (f ? W_DN1 : W_DN0)), T_TOK, 1024, 2816, ACT_LD, 0};
          bf16_t* xb = (bf16_t*)p.out + XB_OFF;
          if (fi == 0) { EpiResidT<true> e{p.in[0], xb, modl + sub * 3072 + 2048, 0.5f}; pg8::gemm_phase(lds, g, e); }
          else { EpiResidT<false> e{xb, xb, modl + sub * 3072 + 2048, 0.5f}; pg8::gemm_phase(lds, g, e); } }
        GSYNC();
        if (f == 0) {
            { const Params p = ldp(); const float* modl = (const float*)(p.ws + S_MOD) + (size_t)l * 4 * 9216;
              phase_norm_b((const bf16_t*)p.out + XB_OFF, (bf16_t*)(p.ws + A_H), p.in[4] + (l * 3 + 1) * 1024, modl + 3072); }
            GSYNC();
            { const Params p = ldp(); pg8::Gemm g{(const bf16_t*)(p.ws + A_H), (const bf16_t*)(p.ws + W_X0), T_TOK, l == 0 ? 4864 : 4096, 1024, 1024, 0};
              EpiProj e{(bf16_t*)(p.ws + A_PROJ), l == 0 ? PROJ_LD : 4096, l == 0 ? 18 : -1, (float*)(p.ws + A_DT)}; pg8::gemm_phase(lds, g, e); }
            GSYNC();
            if (l == 0) {
                { const Params p = ldp(); for (int u = BID(); u < 512; u += GDIM()) ssd_pass1_unit(p, u, sm); }
                GSYNC();
                { const Params p = ldp(); phase_ssd_rec(p); }
                { const Params p = ldp(); phase_lru_conv(p); }
                GSYNC();
                { const Params p = ldp(); for (int u = BID(); u < 512; u += GDIM()) ssd_pass3_unit(p, u, sm); }
                GSYNC();
                { const Params p = ldp(); pg8::Gemm g{(const bf16_t*)(p.ws + A_H), (const bf16_t*)(p.ws + W_LRU), T_TOK, 2048, 256, 1024, 256};
                  EpiLru e{(bf16_t*)(p.ws + A_PROJ), (const bf16_t*)(p.ws + A_H), p.in[13], p.in[15], p.in[16]}; pg8::gemm_phase(lds, g, e); }
                GSYNC();
                { const Params p = ldp(); phase_lru_agg(p); }
                GSYNC();
                { const Params p = ldp(); phase_lru_final(p); }
                GSYNC();
            } else {
                { const Params p = ldp(); phase_ml_conv(p); }
                GSYNC();
                { const Params p = ldp(); phase_ml_intra(p, sm); }
                GSYNC();
                { const Params p = ldp(); for (int it = BID(); it < 256; it += GDIM()) ml_seq_item(p, it, sm, lds); }
                GSYNC();
                { const Params p = ldp(); phase_ml_post(p); }
                GSYNC();
            }
            { const Params p = ldp(); const float* modl = (const float*)(p.ws + S_MOD) + (size_t)l * 4 * 9216;
              pg8::Gemm go = (l == 0) ? pg8::Gemm{(const bf16_t*)(p.ws + A_PROJ), (const bf16_t*)(p.ws + W_HOUT), T_TOK, 1024, 2048, PROJ_LD, 0}
                                      : pg8::Gemm{(const bf16_t*)(p.ws + A_PROJ) + 2048, (const bf16_t*)(p.ws + W_MLDN), T_TOK, 1024, 2048, 4096, 0};
              bf16_t* xb = (bf16_t*)p.out + XB_OFF; EpiResidT<false> e{xb, xb, modl + 3072 + 2048, 1.0f}; pg8::gemm_phase(lds, go, e); }
            GSYNC();
        }
    }
    { const Params p = ldp(); phase_final_norm_b((const bf16_t*)p.out + XB_OFF, p.out, nullptr, p.in[34]); }
}

extern "C" void kernel_launch(void* const* d_in, const int* in_sizes, int n_in, void* d_out, int out_size, void* d_ws, size_t ws_size, hipStream_t stream) {
    static int grid_blocks = 0;
    const size_t ldsb = 163840;
    if (!grid_blocks) {
        (void)hipFuncSetAttribute((const void*)fwd_megakernel, hipFuncAttributeMaxDynamicSharedMemorySize, (int)ldsb);
        int dev = 0, cus = 0, per = 0; (void)hipGetDevice(&dev);
        (void)hipDeviceGetAttribute(&cus, hipDeviceAttributeMultiprocessorCount, dev);
        (void)hipOccupancyMaxActiveBlocksPerMultiprocessor(&per, fwd_megakernel, 512, ldsb);
        if (per < 1) per = 1;
        grid_blocks = cus * per;
    }
    Params p{};
    for (int i = 0; i < 35; ++i) p.in[i] = (const float*)d_in[i];
    p.out = (float*)d_out; p.ws = (unsigned char*)d_ws;
    void* args[] = {&p};
    hipError_t e = hipLaunchCooperativeKernel((void*)fwd_megakernel, dim3(grid_blocks), dim3(512), args, ldsb, stream);
    if (e != hipSuccess) fprintf(stderr, "cooperative launch failed: %s (grid %d)\n", hipGetErrorString(e), grid_blocks);
}
```

```cpp
#include <hip/hip_runtime.h>
#include <hip/hip_cooperative_groups.h>
#include <cstdio>
namespace cg = cooperative_groups;
#define LAS __attribute__((address_space(3)))
typedef unsigned short bf16_t;
typedef short bf16x8 __attribute__((ext_vector_type(8)));
typedef float f32x4 __attribute__((ext_vector_type(4)));
typedef float f32x2 __attribute__((ext_vector_type(2)));
typedef unsigned u32x4 __attribute__((ext_vector_type(4)));
typedef unsigned u32x2 __attribute__((ext_vector_type(2)));
#define MIB (1048576ull)
constexpr int T_TOK = 32768, SEQL = 8192;
constexpr size_t W_GU0 = 0, W_GU1 = 11 * MIB, W_DN0 = 22 * MIB, W_DN1 = 27 * MIB + 524288, W_X0 = 33 * MIB, W_HOUT = 42 * MIB + 524288, W_MLDN = 41 * MIB, W_LRU = 46 * MIB + 524288;
constexpr size_t S_BASE = 48 * MIB, S_MOD = S_BASE, S_WEFF = S_BASE + 524288, S_GQK = S_BASE + 786432, S_CHTOT = S_BASE + 851968, S_RSTD = S_BASE + MIB;
constexpr size_t AR = 50 * MIB, A_PROJ = AR, A_H = AR + 288 * MIB, A_ST = AR + 352 * MIB, A_DT = AR + 416 * MIB;
constexpr size_t A_XC = AR + 256 * MIB, A_SI = AR + 384 * MIB, A_GP = AR + 400 * MIB, A_AUX = AR + 404 * MIB;
constexpr int PROJ_LD = 4608, ACT_LD = 2944, XB_LD = 2048, XB_OFF = 1024;

__device__ __forceinline__ int TID() { int t = threadIdx.x; asm volatile("" : "+v"(t)); return t; }
__device__ __forceinline__ int BID() { int t = blockIdx.x; asm volatile("" : "+s"(t)); return t; }
__device__ __forceinline__ int GDIM() { int t = gridDim.x; asm volatile("" : "+s"(t)); return t; }
struct Params { const float* in[35]; float* out; unsigned char* ws; };

__device__ __forceinline__ float bf2f(unsigned short v) { return __uint_as_float(((unsigned)v) << 16); }
typedef __bf16 bf16n2 __attribute__((ext_vector_type(2)));
__device__ __forceinline__ unsigned pk2(float lo, float hi) { const f32x2 v = {lo, hi}; const bf16n2 r = __builtin_convertvector(v, bf16n2); return __builtin_bit_cast(unsigned, r); }
__device__ __forceinline__ float siluf(float x) { return x * __builtin_amdgcn_rcpf(1.f + __expf(-x)); }
__device__ __forceinline__ float sigmf(float x) { return __builtin_amdgcn_rcpf(1.f + __expf(-x)); }
__device__ __forceinline__ float softplusf(float x) { return fmaxf(x, 0.f) + __logf(1.0f + __expf(-fabsf(x))); }
__device__ __forceinline__ float gelu_tanh(float x) { float u = 0.7978845608f * (x + 0.044715f * x * x * x); float e = __expf(2.f * u); float th = 1.f - 2.f * __builtin_amdgcn_rcpf(e + 1.f); return 0.5f * x * (1.f + th); }
#define UNPACK8(v, f) do { f[0] = __uint_as_float((v).x << 16); f[1] = __uint_as_float((v).x & 0xffff0000u); f[2] = __uint_as_float((v).y << 16); f[3] = __uint_as_float((v).y & 0xffff0000u); \
  f[4] = __uint_as_float((v).z << 16); f[5] = __uint_as_float((v).z & 0xffff0000u); f[6] = __uint_as_float((v).w << 16); f[7] = __uint_as_float((v).w & 0xffff0000u); } while (0)
#define PACK8(f) ((u32x4){pk2(f[0], f[1]), pk2(f[2], f[3]), pk2(f[4], f[5]), pk2(f[6], f[7])})

namespace pg8 {
constexpr int BM = 256, BK = 64, HALF = 128, HTB = HALF * BK * 2, STAGE_BYTES = 8 * HTB, NXCD = 8, WGM = 8;
__device__ __forceinline__ int lds_byte(int r, int c) { const int st = (r >> 4) * 2 + (c >> 5), rr = r & 15, cc = c & 31, ob = rr * 64 + cc * 2; return st * 1024 + (ob ^ (((ob >> 9) & 1) << 5)); }
__device__ __forceinline__ void stage_rc(int b, int& R, int& C) { const int st = b / 1024, sb = b % 1024, swz = sb ^ (((sb >> 9) & 1) << 5); R = (st >> 1) * 16 + swz / 64; C = (st & 1) * 32 + (swz % 64) / 2; }
__device__ __forceinline__ int perm32(int rho) { const int n = rho >> 4, i = rho & 15; return 8 * (i >> 2) + 4 * n + (i & 3); }
struct Unit { int pm, pn; };
struct Gemm { const bf16_t* A; const bf16_t* Bt; int M, N, K, lda, akoff; };
struct StaticOrder {
    int nM, nN, nwg, G, c;
    __device__ void init(int M, int N, int G_, int c_) { nM = M / BM; nN = N / BM; nwg = nM * nN; G = G_; c = c_; }
    __device__ bool next(int i, Unit& u) const {
        const long L = (long)i * G + c; if (L >= nwg) return false;
        int wgid = (int)L; { const int q = nwg / NXCD, r = nwg % NXCD, xcd = wgid % NXCD, off = wgid / NXCD; wgid = (xcd < r ? xcd * (q + 1) : r * (q + 1) + (xcd - r) * q) + off; }
        const int nig = WGM * nN, gid = wgid / nig, fm = gid * WGM, gsz = (nM - fm) < WGM ? (nM - fm) : WGM;
        u.pm = fm + ((wgid % nig) % gsz); u.pn = (wgid % nig) / gsz; return true;
    }
};
template <class Epi>
__device__ __forceinline__ void gemm_phase(LAS unsigned char* lds, const Gemm g, const Epi& E) {
    StaticOrder S; S.init(g.M, g.N, (int)GDIM(), (int)BID());
    const int tid = TID(), wid = __builtin_amdgcn_readfirstlane(tid >> 6), lane = tid & 63, wr = wid >> 2, wc = wid & 3, fr = lane & 15, fq = lane >> 4;
    const int K = g.K, nt = K / BK;
    unsigned voffA[2], voffB[2];
#pragma unroll
    for (int i = 0; i < 2; ++i) { int R, C; stage_rc(tid * 16 + i * 8192, R, C); const int Rb = Epi::PERM ? ((R & ~31) + perm32(R & 31)) : R;
        voffA[i] = (unsigned)(R * g.lda + C) * 2u; voffB[i] = (unsigned)(Rb * K + C) * 2u; }
    const size_t kstep = (size_t)(BK * 2);
    const size_t hstepA = (size_t)HALF * g.lda * 2, hstepB = (size_t)HALF * K * 2;
    const size_t tstepA = 2 * hstepA, tstepB = 2 * hstepB;
    const unsigned ldsw = (unsigned)wid * 1024u;
    const int aoff = lds_byte(wr * 64 + fr, fq * 8), boff = lds_byte(wc * 32 + fr, fq * 8);
#define PG8_SA(b, h) (((b) * 2 + (h)) * HTB)
#define PG8_SB(b, h) ((4 + (b) * 2 + (h)) * HTB)
#define PG8_STAGE(bufoff, gbase, voff) do { _Pragma("unroll") for (int _i = 0; _i < 2; ++_i) \
        __builtin_amdgcn_global_load_lds((const unsigned*)((const char*)(gbase) + (voff)[_i]), (LAS unsigned*)(lds + (bufoff) + ldsw + _i * 8192), 16, 0, 0); } while (0)
#define PG8_LDA(dst, b, h) do { _Pragma("unroll") for (int m = 0; m < 4; ++m) _Pragma("unroll") for (int k = 0; k < 2; ++k) dst[m][k] = *(const LAS bf16x8*)(lds + PG8_SA(b, h) + aoff + m * 2048 + k * 1024); } while (0)
#define PG8_LDB(dst, b, h) do { _Pragma("unroll") for (int n = 0; n < 2; ++n) _Pragma("unroll") for (int k = 0; k < 2; ++k) dst[n][k] = *(const LAS bf16x8*)(lds + PG8_SB(b, h) + boff + n * 2048 + k * 1024); } while (0)
#define PG8_MMA(ai, bj, At, Bt) do { __builtin_amdgcn_s_setprio(1); _Pragma("unroll") for (int m = 0; m < 4; ++m) _Pragma("unroll") for (int n = 0; n < 2; ++n) _Pragma("unroll") for (int k = 0; k < 2; ++k) \
        acc[ai][bj][m][n] = __builtin_amdgcn_mfma_f32_16x16x32_bf16(Bt[n][k], At[m][k], acc[ai][bj][m][n], 0, 0, 0); __builtin_amdgcn_s_setprio(0); } while (0)
#define PG8_WAIT_V(n) asm volatile("s_waitcnt vmcnt(" #n ")" ::: "memory")
#define PG8_WAIT_L(n) asm volatile("s_waitcnt lgkmcnt(" #n ")" ::: "memory")
#define PG8_BAR __builtin_amdgcn_s_barrier()
#define PG8_SCHED __builtin_amdgcn_sched_barrier(0)
    Unit cur, nxt; int ui = 0;
    if (!S.next(0, cur)) return;
    f32x4 acc[2][2][4][2];
#pragma unroll
    for (int a = 0; a < 2; ++a)
#pragma unroll
        for (int b = 0; b < 2; ++b)
#pragma unroll
            for (int m = 0; m < 4; ++m)
#pragma unroll
                for (int n = 0; n < 2; ++n) acc[a][b][m][n] = (f32x4){0.f, 0.f, 0.f, 0.f};
    bf16x8 At[4][2], B0[2][2], B1[2][2];
    const char* cA = (const char*)g.A + (size_t)cur.pm * tstepA + (size_t)((cur.pn >> 1) * g.akoff) * 2; const char* cB = (const char*)g.Bt + (size_t)cur.pn * tstepB;
    PG8_STAGE(PG8_SB(0, 0), cB, voffB); PG8_STAGE(PG8_SA(0, 0), cA, voffA); PG8_STAGE(PG8_SB(0, 1), cB + hstepB, voffB); PG8_STAGE(PG8_SA(0, 1), cA + hstepA, voffA);
    if (wr == 1) PG8_BAR;
    PG8_WAIT_V(4); PG8_BAR;
    PG8_STAGE(PG8_SB(1, 0), cB + kstep, voffB); PG8_STAGE(PG8_SA(1, 0), cA + kstep, voffA); PG8_STAGE(PG8_SB(1, 1), cB + hstepB + kstep, voffB);
    PG8_WAIT_V(6); PG8_BAR;
    for (;;) {
        const bool has_next = S.next(ui + 1, nxt);
        const char* nA = has_next ? (const char*)g.A + (size_t)nxt.pm * tstepA + (size_t)((nxt.pn >> 1) * g.akoff) * 2 : cA; const char* nB = has_next ? (const char*)g.Bt + (size_t)nxt.pn * tstepB : cB;
        for (int t = 0; t < nt; t += 2) {
            const bool last = (t == nt - 2);
            const char* a1 = cA + (size_t)(t + 1) * kstep;
            const char* a2 = last ? nA : cA + (size_t)(t + 2) * kstep; const char* b2 = last ? nB : cB + (size_t)(t + 2) * kstep;
            const char* a3 = a2 + kstep; const char* b3 = b2 + kstep;
            PG8_LDB(B0, 0, 0); PG8_SCHED; PG8_LDA(At, 0, 0); PG8_STAGE(PG8_SA(1, 1), a1 + hstepA, voffA);
            PG8_WAIT_L(8); PG8_BAR; PG8_WAIT_L(0); PG8_MMA(0, 0, At, B0); PG8_BAR; PG8_SCHED;
            PG8_LDB(B1, 0, 1); PG8_STAGE(PG8_SB(0, 0), b2, voffB);
            PG8_BAR; PG8_WAIT_L(0); PG8_MMA(0, 1, At, B1); PG8_BAR;
            PG8_LDA(At, 0, 1); PG8_STAGE(PG8_SA(0, 0), a2, voffA);
            PG8_BAR; PG8_WAIT_L(0); PG8_MMA(1, 0, At, B0); PG8_BAR; PG8_SCHED;
            PG8_STAGE(PG8_SB(0, 1), b2 + hstepB, voffB);
            PG8_WAIT_V(6); PG8_BAR; PG8_MMA(1, 1, At, B1); PG8_BAR;
            PG8_LDB(B0, 1, 0); PG8_SCHED; PG8_LDA(At, 1, 0); PG8_STAGE(PG8_SA(0, 1), a2 + hstepA, voffA);
            PG8_WAIT_L(8); PG8_BAR; PG8_WAIT_L(0); PG8_MMA(0, 0, At, B0); PG8_BAR; PG8_SCHED;
            PG8_LDB(B1, 1, 1); PG8_STAGE(PG8_SB(1, 0), b3, voffB);
            PG8_BAR; PG8_WAIT_L(0); PG8_MMA(0, 1, At, B1); PG8_BAR;
            PG8_LDA(At, 1, 1); PG8_STAGE(PG8_SA(1, 0), a3, voffA);
            PG8_BAR; PG8_WAIT_L(0); PG8_MMA(1, 0, At, B0); PG8_BAR; PG8_SCHED;
            PG8_STAGE(PG8_SB(1, 1), b3 + hstepB, voffB);
            PG8_WAIT_V(6); PG8_BAR; PG8_MMA(1, 1, At, B1); PG8_BAR;
        }
        E(acc, cur, wr, wc, fr, fq);
        if (!has_next) break;
#pragma unroll
        for (int a = 0; a < 2; ++a)
#pragma unroll
            for (int b = 0; b < 2; ++b)
#pragma unroll
                for (int m = 0; m < 4; ++m)
#pragma unroll
                    for (int n = 0; n < 2; ++n) acc[a][b][m][n] = (f32x4){0.f, 0.f, 0.f, 0.f};
        cur = nxt; cA = nA; cB = nB; ++ui;
    }
    PG8_WAIT_V(0);
    if (wr == 0) PG8_BAR;
    PG8_BAR;
}
}
using pg8::Unit;
typedef f32x4 AccT[2][2][4][2];

struct EpiSwiglu { static constexpr bool PERM = true; bf16_t* O;
    __device__ __forceinline__ void operator()(const AccT& acc, const Unit& u, int wr, int wc, int fr, int fq) const {
        const int row0 = u.pm * 256 + wr * 64 + fr, col = u.pn * 128 + wc * 32 + 8 * fq;
#pragma unroll
        for (int ai = 0; ai < 2; ++ai)
#pragma unroll
            for (int m = 0; m < 4; ++m) {
                float v[8];
#pragma unroll
                for (int n = 0; n < 2; ++n)
#pragma unroll
                    for (int j = 0; j < 4; ++j) v[4 * n + j] = siluf(acc[ai][0][m][n][j]) * acc[ai][1][m][n][j];
                *(u32x4*)(O + (size_t)(row0 + ai * 128 + m * 16) * ACT_LD + col) = PACK8(v);
            }
    } };
template <bool SRCF32> struct EpiResidT { static constexpr bool PERM = true; const void* src; bf16_t* dst; const float* gate; float coef;
    __device__ __forceinline__ void operator()(const AccT& acc, const Unit& u, int wr, int wc, int fr, int fq) const {
        const int row0 = u.pm * 256 + wr * 64 + fr, col0 = u.pn * 256 + wc * 32 + 8 * fq;
        const float* gp = gate + (size_t)(u.pm >> 5) * 9216 + col0;
        f32x4 gv[2][2];
#pragma unroll
        for (int bj = 0; bj < 2; ++bj)
#pragma unroll
            for (int n = 0; n < 2; ++n) gv[bj][n] = (*(const f32x4*)(gp + bj * 128 + n * 4) + 1.0f) * coef;
#pragma unroll
        for (int ai = 0; ai < 2; ++ai)
#pragma unroll
            for (int m = 0; m < 4; ++m) { const size_t rr = (size_t)(row0 + ai * 128 + m * 16);
#pragma unroll
                for (int bj = 0; bj < 2; ++bj) { const size_t o = rr * XB_LD + col0 + bj * 128; float xv[8], y[8];
                    if (SRCF32) { const size_t of = rr * 1024 + col0 + bj * 128; const f32x4 a = *(const f32x4*)((const float*)src + of), b = *(const f32x4*)((const float*)src + of + 4);
#pragma unroll
                        for (int e = 0; e < 4; ++e) { xv[e] = a[e]; xv[4 + e] = b[e]; } }
                    else { const u32x4 r = *(const u32x4*)((const bf16_t*)src + o); UNPACK8(r, xv); }
#pragma unroll
                    for (int n = 0; n < 2; ++n)
#pragma unroll
                        for (int jj = 0; jj < 4; ++jj) y[4 * n + jj] = xv[4 * n + jj] + gv[bj][n][jj] * acc[ai][bj][m][n][jj];
                    *(u32x4*)(dst + o) = PACK8(y); } }
    } };
struct EpiProj { static constexpr bool PERM = true; bf16_t* O; int ldc; int dt_pn; float* dt;
    __device__ __forceinline__ void operator()(const AccT& acc, const Unit& u, int wr, int wc, int fr, int fq) const {
        const int row0 = u.pm * 256 + wr * 64 + fr;
        if (u.pn == dt_pn) {
            if (wc == 0 && fq < 2) {
#pragma unroll
                for (int ai = 0; ai < 2; ++ai)
#pragma unroll
                    for (int m = 0; m < 4; ++m)
#pragma unroll
                        for (int n = 0; n < 2; ++n) *(f32x4*)(dt + (size_t)(row0 + ai * 128 + m * 16) * 16 + 8 * fq + 4 * n) = acc[ai][0][m][n];
            }
            return;
        }
        const int col = u.pn * 256 + wc * 32 + 8 * fq;
#pragma unroll
        for (int ai = 0; ai < 2; ++ai)
#pragma unroll
            for (int m = 0; m < 4; ++m)
#pragma unroll
                for (int bj = 0; bj < 2; ++bj) {
                    float v[8];
#pragma unroll
                    for (int n = 0; n < 2; ++n)
#pragma unroll
                        for (int j = 0; j < 4; ++j) v[4 * n + j] = acc[ai][bj][m][n][j];
                    *(u32x4*)(O + (size_t)(row0 + ai * 128 + m * 16) * ldc + col + bj * 128) = PACK8(v);
                }
    } };
struct EpiLru { static constexpr bool PERM = true; bf16_t* proj; const bf16_t* xconv; const float* ba; const float* bx; const float* lam;
    __device__ __forceinline__ void operator()(const AccT& acc, const Unit& u, int wr_, int wc_, int fr_, int fq_) const {
        const int t_ = TID(), wr = t_ >> 8, wc = (t_ >> 6) & 3, fr = t_ & 15, fq = (t_ >> 4) & 3;
        const int row0 = u.pm * 256 + wr * 64 + fr, ch0 = u.pn * 128 + wc * 32 + 8 * fq;
#pragma unroll
        for (int n = 0; n < 2; ++n) { const int ch = ch0 + 4 * n;
            const f32x4 vba = *(const f32x4*)(ba + ch), vbx = *(const f32x4*)(bx + ch), vl = *(const f32x4*)(lam + ch); f32x4 vsp;
#pragma unroll
            for (int j = 0; j < 4; ++j) vsp[j] = -8.0f * softplusf(-vl[j]);
            int rowi = row0;
#pragma unroll
            for (int ai = 0; ai < 2; ++ai)
#pragma unroll
                for (int m = 0; m < 4; ++m) {
                    asm volatile("" : "+v"(rowi));
                    const size_t row = (size_t)rowi; rowi += (m == 3) ? 80 : 16;
                    const u32x2 xr = *(const u32x2*)(xconv + row * 1024 + ch);
                    const float xv[4] = {__uint_as_float(xr.x << 16), __uint_as_float(xr.x & 0xffff0000u), __uint_as_float(xr.y << 16), __uint_as_float(xr.y & 0xffff0000u)};
                    float la[4], uu[4];
#pragma unroll
                    for (int j = 0; j < 4; ++j) { const float r = sigmf(acc[ai][0][m][n][j] + vba[j]), ig = sigmf(acc[ai][1][m][n][j] + vbx[j]);
                        const float l = r * vsp[j]; la[j] = l; uu[j] = __builtin_amdgcn_sqrtf(fmaxf(1.0f - __expf(2.0f * l), 0.f)) * ig * xv[j]; }
                    u32x2 w0; w0.x = pk2(la[0], la[1]); w0.y = pk2(la[2], la[3]); *(u32x2*)(proj + row * PROJ_LD + 3072 + ch) = w0;
                    u32x2 w1; w1.x = pk2(uu[0], uu[1]); w1.y = pk2(uu[2], uu[3]); *(u32x2*)(proj + row * PROJ_LD + 2048 + ch) = w1;
                } }
    } };
#define XB_TMO      128
#define XB_XCNT(j)  (256  + 64 * (j))
#define XB_XSUB(j)  (1280 + 64 * (j))
#define XB_XGEN(j)  (2304 + 64 * (j))
#define XB_TOP      3328
#define XB_TOPGEN   3392
#define XCD_BAR_WORDS 3456
#define XB_SPIN_CAP (1u << 20)
constexpr size_t S_BAR = S_BASE + MIB + 786432;
__device__ __forceinline__ unsigned xb_ld(unsigned* p)              { return __hip_atomic_load(p, __ATOMIC_RELAXED, __HIP_MEMORY_SCOPE_AGENT); }
__device__ __forceinline__ unsigned xb_add(unsigned* p, unsigned v) { return __hip_atomic_fetch_add(p, v, __ATOMIC_RELAXED, __HIP_MEMORY_SCOPE_AGENT); }
__device__ __forceinline__ unsigned xb_xcc_id() { return (unsigned)__builtin_amdgcn_s_getreg((3 << 11) | 20) & 0xFu; }
#define XB_SPIN(cond, bar) do { unsigned _sp = 0; while (cond) { __builtin_amdgcn_s_sleep(1); \
    if ((++_sp & 255u) == 0u) { if (xb_ld(&(bar)[XB_TMO])) break; if (_sp > XB_SPIN_CAP) { atomicAdd(&(bar)[XB_TMO], 1u); break; } } } } while (0)
struct XcdBarrier { unsigned* bar; unsigned x; volatile LAS unsigned* st; };
__device__ __forceinline__ void xcd_barrier_post(unsigned* bar) { if (threadIdx.x == 0) (void)xb_add(&bar[XB_XCNT(xb_xcc_id())], 1u); }
__device__ __forceinline__ void xcd_barrier_complete(unsigned* bar, unsigned x, unsigned& nloc, unsigned& nx) {
    const unsigned G = gridDim.x * gridDim.y * gridDim.z;
    unsigned sum, cnt, mine, sp = 0u;
    for (;;) {
        sum = 0u; cnt = 0u; mine = 0u;
#pragma unroll
        for (unsigned j = 0; j < 16; ++j) { const unsigned c = xb_ld(&bar[XB_XCNT(j)]); sum += c; cnt += (c > 0u) ? 1u : 0u; mine = (j == x) ? c : mine; }
        if (sum == G) break;
        __builtin_amdgcn_s_sleep(1);
        if ((++sp & 255u) == 0u) { if (xb_ld(&bar[XB_TMO])) break; if (sp > XB_SPIN_CAP) { atomicAdd(&bar[XB_TMO], 1u); break; } }
    }
    nloc = mine > 0u ? mine : 1u; nx = cnt > 0u ? cnt : 1u;
}
__device__ __forceinline__ void xcd_barrier(const XcdBarrier& b) {
    asm volatile("s_waitcnt vmcnt(0)" ::: "memory");
    __syncthreads();
    if (threadIdx.x == 0) {
        unsigned* bar = b.bar;
        __builtin_amdgcn_s_waitcnt(0);
        unsigned nloc = b.st[0], nx = b.st[1];
        if (nloc == 0u) { xcd_barrier_complete(bar, b.x, nloc, nx); b.st[0] = nloc; b.st[1] = nx; }
        const unsigned old = xb_add(&bar[XB_XSUB(b.x)], 1u);
        const unsigned gen = old / nloc;
        if (old + 1u == (gen + 1u) * nloc) {
            __builtin_amdgcn_fence(__ATOMIC_RELEASE, "agent");
            asm volatile("s_waitcnt vmcnt(0)" ::: "memory");
            const unsigned og = xb_add(&bar[XB_TOP], 1u);
            const unsigned tg = og / nx;
            if (og + 1u == (tg + 1u) * nx) xb_add(&bar[XB_TOPGEN], 1u);
            else XB_SPIN(xb_ld(&bar[XB_TOPGEN]) == tg, bar);
            __builtin_amdgcn_fence(__ATOMIC_ACQUIRE, "agent");
            xb_add(&bar[XB_XGEN(b.x)], 1u);
            asm volatile("s_waitcnt vmcnt(0)" ::: "memory");
        } else {
            XB_SPIN(xb_ld(&bar[XB_XGEN(b.x)]) == gen, bar);
            __builtin_amdgcn_fence(__ATOMIC_ACQUIRE, "agent");
            asm volatile("s_waitcnt vmcnt(0)" ::: "memory");
        }
    }
    __syncthreads();
}
struct CvtJob { const float* s0; const float* s1; bf16_t* dst; int K, ld, mode, tile; };
__device__ __forceinline__ CvtJob cvt_decode(const Params& p, int l, int t) {
    CvtJob j;
    if (t < 2816) { const int f = t / 1408; const size_t o = (size_t)(l * 2 + f) * 1024 * 2816; j = CvtJob{p.in[5] + o, p.in[6] + o, (bf16_t*)(p.ws + (f ? W_GU1 : W_GU0)), 1024, 2816, 1, t % 1408}; }
    else if (t < 4224) { t -= 2816; const int f = t / 704; const size_t o = (size_t)(l * 2 + f) * 1024 * 2816; j = CvtJob{p.in[7] + o, nullptr, (bf16_t*)(p.ws + (f ? W_DN1 : W_DN0)), 2816, 1024, 0, t % 704}; }
    else if (l == 0) { t -= 4224; if (t < 1216) j = CvtJob{p.in[8], nullptr, (bf16_t*)(p.ws + W_X0), 1024, 4624, 2, t}; else j = CvtJob{p.in[9], nullptr, (bf16_t*)(p.ws + W_HOUT), 2048, 1024, 0, t - 1216}; }
    else { t -= 4224; if (t < 1024) j = CvtJob{p.in[23], nullptr, (bf16_t*)(p.ws + W_X0), 1024, 4096, 0, t}; else j = CvtJob{p.in[33], nullptr, (bf16_t*)(p.ws + W_MLDN), 2048, 1024, 0, t - 1024}; }
    return j;
}
__device__ __forceinline__ void cvt_load(const CvtJob& jb, float* v) {
    const int tid = TID(); const int ktiles = jb.K >> 6; const int r0 = (jb.tile / ktiles) * 64, k0 = (jb.tile % ktiles) * 64;
    const int r = tid & 63, kk = tid >> 6, row = r0 + r; const float* pp = jb.s0 + row; bool valid = true;
    if (jb.mode == 1) { const int pn = row >> 8, bj = (row >> 7) & 1, rr = row & 127; pp = (bj ? jb.s1 : jb.s0) + pn * 128 + rr; }
    else if (jb.mode == 2) { int col = row; if (row >= 1024 && row < 2048) col = row + 1024; else if (row >= 2048 && row < 3072) col = row - 1024; valid = row < 4624; pp = jb.s0 + (valid ? col : 0); }
#pragma unroll
    for (int i = 0; i < 8; ++i) { const int k = kk + 8 * i; v[i] = valid ? pp[(size_t)(k0 + k) * jb.ld] : 0.f; }
}
__device__ __forceinline__ void cvt_store(const CvtJob& jb, const float* v, float* tl) {
    const int tid = TID(); const int ktiles = jb.K >> 6; const int r0 = (jb.tile / ktiles) * 64, k0 = (jb.tile % ktiles) * 64;
    { const int r = tid & 63, kk = tid >> 6;
#pragma unroll
      for (int i = 0; i < 8; ++i) tl[(kk + 8 * i) * 65 + r] = v[i]; }
    __syncthreads();
    { const int r = tid >> 3, kq = (tid & 7) * 8; float o[8];
#pragma unroll
      for (int e = 0; e < 8; ++e) o[e] = tl[(kq + e) * 65 + r];
      *(u32x4*)(jb.dst + (size_t)(r0 + r) * jb.K + k0 + kq) = PACK8(o); }
    __syncthreads();
}
__device__ __forceinline__ void cvt_all(const Params& p, int l, int total, float* tl) {
    int t = BID(); if (t >= total) return;
    const int G = GDIM();
    CvtJob jb = cvt_decode(p, l, t); float v[8], vn[8]; cvt_load(jb, v);
    for (;;) { const int tn = t + G; CvtJob jn = jb; const bool more = tn < total;
        if (more) { jn = cvt_decode(p, l, tn); cvt_load(jn, vn); }
        cvt_store(jb, v, tl);
        if (!more) break;
#pragma unroll
        for (int i = 0; i < 8; ++i) v[i] = vn[i];
        jb = jn; t = tn; }
}
__device__ __forceinline__ void phase_prologue(const Params& p, unsigned char* sm) {
    float* tl = (float*)sm;
    cvt_all(p, 0, 4224 + 1216 + 512, tl);
    { bf16_t* bt = (bf16_t*)(p.ws + W_LRU);
      for (int idx = BID() * 512 + TID(); idx < 2048 * 256; idx += GDIM() * 512) {
          const int row = idx >> 8, kl = idx & 255, pn = row >> 8, bj = (row >> 7) & 1, o = row & 127, kin = kl - (pn & 1) * 128;
          float v = 0.f; if (kin >= 0 && kin < 128) v = (bj ? p.in[14] : p.in[12])[(size_t)(pn * 128 + kin) * 128 + o];
          bt[idx] = (bf16_t)(pk2(v, v) & 0xffffu); } }
    { float* cact = (float*)sm; float* red = cact + 4096; float* mod = (float*)(p.ws + S_MOD);
      __syncthreads();
      for (int i = TID(); i < 4096; i += 512) cact[i] = siluf(p.in[1][i]);
      __syncthreads();
      for (int it = BID(); it < 256; it += GDIM()) {
          const int l = it >> 7, jg = it & 127, tidm = TID(), cc = tidm % 72, kp = tidm / 72, col = jg * 72 + cc;
          float a0 = 0.f, a1 = 0.f, a2 = 0.f, a3 = 0.f;
          if (kp < 7) { const int k0 = kp * 146 + (kp < 2 ? kp : 2), kn = 146 + (kp < 2 ? 1 : 0); const float* w = p.in[2] + (size_t)l * 1024 * 9216 + col;
              int k = k0;
#pragma unroll 1
              for (; k + 8 <= k0 + kn; k += 8) { float wv[8];
#pragma unroll
                  for (int i = 0; i < 8; ++i) wv[i] = w[(size_t)(k + i) * 9216];
#pragma unroll
                  for (int i = 0; i < 8; ++i) { a0 += cact[k + i] * wv[i]; a1 += cact[1024 + k + i] * wv[i]; a2 += cact[2048 + k + i] * wv[i]; a3 += cact[3072 + k + i] * wv[i]; } }
              for (; k < k0 + kn; ++k) { const float wv = w[(size_t)k * 9216]; a0 += cact[k] * wv; a1 += cact[1024 + k] * wv; a2 += cact[2048 + k] * wv; a3 += cact[3072 + k] * wv; }
              float* rp = red + (kp * 72 + cc) * 4; rp[0] = a0; rp[1] = a1; rp[2] = a2; rp[3] = a3; }
          __syncthreads();
          if (tidm < 288) { const int c2 = tidm % 72, b = tidm / 72; float sacc = p.in[3][l * 9216 + jg * 72 + c2];
#pragma unroll
              for (int q = 0; q < 7; ++q) sacc += red[(q * 72 + c2) * 4 + b];
              mod[(size_t)(l * 4 + b) * 9216 + jg * 72 + c2] = sacc; }
          __syncthreads();
      } }
}
__device__ __forceinline__ void phase_cvt_l1(const Params& p, unsigned char* sm) {
    float* tl = (float*)sm;
    cvt_all(p, 1, 4224 + 1024 + 512, tl);
    float* weff = (float*)(p.ws + S_WEFF); float* gqk = (float*)(p.ws + S_GQK);
    const float* wq = p.in[26]; const float* wk = p.in[27]; const float* wv = p.in[28]; const float* wg = p.in[29];
    for (int idx = BID() * 512 + TID(); idx < 2048 * 8; idx += GDIM() * 512) {
        const int c = idx >> 3, g = idx & 7, blk = c >> 2, i = c & 3; float s = 0.f, sv = 0.f;
#pragma unroll
        for (int o = 0; o < 4; ++o) { s += wq[blk * 16 + i * 4 + o] * wg[(size_t)(blk * 4 + o) * 8 + g] + wk[blk * 16 + i * 4 + o] * wg[(size_t)(2048 + blk * 4 + o) * 8 + g];
            sv += wv[blk * 16 + i * 4 + o] * wg[(size_t)(4096 + blk * 4 + o) * 8 + g]; }
        weff[idx] = s; weff[2048 * 8 + idx] = sv; }
    for (int idx = BID() * 512 + TID(); idx < 512 * 16; idx += GDIM() * 512) {
        const int blk = idx >> 4, i = (idx >> 2) & 3, i2 = idx & 3; float s = 0.f;
#pragma unroll
        for (int o = 0; o < 4; ++o) s += wq[blk * 16 + i * 4 + o] * wk[blk * 16 + i2 * 4 + o];
        gqk[idx] = s * 0.04419417382f; }
}
template <bool FINAL>
__device__ __forceinline__ void norm_rows(const float* x, bf16_t* h, float* xo, const float* g, const float* modl) {
    const int lane = TID() & 63, wg = BID() * 8 + (TID() >> 6), nw = GDIM() * 8;
    const int rpw = (T_TOK + nw - 1) / nw, r0 = wg * rpw, r1 = min(T_TOK, r0 + rpw);
    if (r0 >= r1) return;
    f32x4 gs[4], sh[4]; int curb = -1;
    f32x4 v[4], nx[4];
#pragma unroll
    for (int i = 0; i < 4; ++i) { v[i] = *(const f32x4*)(x + (size_t)r0 * 1024 + i * 256 + lane * 4); nx[i] = v[i]; }
    for (int row = r0; row < r1; ++row) {
        if (row + 1 < r1) {
#pragma unroll
            for (int i = 0; i < 4; ++i) nx[i] = *(const f32x4*)(x + (size_t)(row + 1) * 1024 + i * 256 + lane * 4); }
        if ((row >> 13) != curb) { curb = row >> 13;
#pragma unroll
            for (int i = 0; i < 4; ++i) { const int c = i * 256 + lane * 4; gs[i] = *(const f32x4*)(g + c);
                if (!FINAL) { const float* mb = modl + (size_t)curb * 9216; gs[i] = gs[i] * (*(const f32x4*)(mb + 1024 + c) + 1.0f); sh[i] = *(const f32x4*)(mb + c); } } }
        float ss = 0.f;
#pragma unroll
        for (int i = 0; i < 4; ++i) ss += v[i][0] * v[i][0] + v[i][1] * v[i][1] + v[i][2] * v[i][2] + v[i][3] * v[i][3];
#pragma unroll
        for (int o = 32; o >= 1; o >>= 1) ss += __shfl_xor(ss, o);
        const float rstd = rsqrtf(ss * (1.0f / 1024.0f) + 1e-6f);
#pragma unroll
        for (int i = 0; i < 4; ++i) { const int c = i * 256 + lane * 4;
            if (FINAL) { *(f32x4*)(xo + (size_t)row * 1024 + c) = v[i] * rstd * gs[i]; }
            else { const f32x4 y = v[i] * rstd * gs[i] + sh[i]; u32x2 w; w.x = pk2(y[0], y[1]); w.y = pk2(y[2], y[3]); *(u32x2*)(h + (size_t)row * 1024 + c) = w; }
            v[i] = nx[i]; }
    }
}
__device__ __forceinline__ void phase_norm(const float* x, bf16_t* h, const float* g, const float* modl) { norm_rows<false>(x, h, nullptr, g, modl); }
template <bool FINAL>
__device__ __forceinline__ void norm_rows_b(const bf16_t* x, bf16_t* h, float* out_lo, float* out_hi, const float* g, const float* modl) {
    const int lane = TID() & 63, wg = BID() * 8 + (TID() >> 6), nw = GDIM() * 8;
    const int rpw = (T_TOK + nw - 1) / nw, r0 = wg * rpw, r1 = min(T_TOK, r0 + rpw);
    if (r0 >= r1) return;
    float gs[16], sh[16]; int curb = -1;
    u32x4 v0 = *(const u32x4*)(x + (size_t)r0 * XB_LD + lane * 8), v1 = *(const u32x4*)(x + (size_t)r0 * XB_LD + 512 + lane * 8), n0 = v0, n1 = v1;
    for (int row = r0; row < r1; ++row) {
        if (row + 1 < r1) { n0 = *(const u32x4*)(x + (size_t)(row + 1) * XB_LD + lane * 8); n1 = *(const u32x4*)(x + (size_t)(row + 1) * XB_LD + 512 + lane * 8); }
        if ((row >> 13) != curb) { curb = row >> 13;
#pragma unroll
            for (int i = 0; i < 2; ++i)
#pragma unroll
                for (int q = 0; q < 2; ++q) { const int c = i * 512 + lane * 8 + q * 4; f32x4 gg = *(const f32x4*)(g + c), ss4 = (f32x4){0.f, 0.f, 0.f, 0.f};
                    if (!FINAL) { const float* mb = modl + (size_t)curb * 9216; gg = gg * (*(const f32x4*)(mb + 1024 + c) + 1.0f); ss4 = *(const f32x4*)(mb + c); }
#pragma unroll
                    for (int e = 0; e < 4; ++e) { gs[i * 8 + q * 4 + e] = gg[e]; sh[i * 8 + q * 4 + e] = ss4[e]; } } }
        float xv[16]; { float t8[8]; UNPACK8(v0, t8);
#pragma unroll
            for (int e = 0; e < 8; ++e) xv[e] = t8[e];
            UNPACK8(v1, t8);
#pragma unroll
            for (int e = 0; e < 8; ++e) xv[8 + e] = t8[e]; }
        float ss = 0.f;
#pragma unroll
        for (int e = 0; e < 16; ++e) ss += xv[e] * xv[e];
#pragma unroll
        for (int o = 32; o >= 1; o >>= 1) ss += __shfl_xor(ss, o);
        const float rstd = rsqrtf(ss * (1.0f / 1024.0f) + 1e-6f);
        if (FINAL) { float* dp = out_lo + (size_t)row * 1024;
#pragma unroll
            for (int i = 0; i < 2; ++i)
#pragma unroll
                for (int q = 0; q < 2; ++q) { f32x4 y;
#pragma unroll
                    for (int e = 0; e < 4; ++e) y[e] = xv[i * 8 + q * 4 + e] * rstd * gs[i * 8 + q * 4 + e];
                    *(f32x4*)(dp + i * 512 + lane * 8 + q * 4) = y; } }
        else {
#pragma unroll
            for (int i = 0; i < 2; ++i) { float y[8];
#pragma unroll
                for (int e = 0; e < 8; ++e) y[e] = xv[i * 8 + e] * rstd * gs[i * 8 + e] + sh[i * 8 + e];
                *(u32x4*)(h + (size_t)row * 1024 + i * 512 + lane * 8) = PACK8(y); } }
        v0 = n0; v1 = n1;
    }
}
__device__ __forceinline__ void phase_norm_b(const bf16_t* x, bf16_t* h, const float* g, const float* modl) { norm_rows_b<false>(x, h, nullptr, nullptr, g, modl); }
__device__ __forceinline__ void phase_final_norm_b(const bf16_t* x, float* out_lo, float* tmp_hi, const float* g) { norm_rows_b<true>(x, nullptr, out_lo, tmp_hi, g, nullptr); }
__device__ __forceinline__ void phase_copy_hi(const float* tmp, float* dst) {
    const size_t n4 = (size_t)16384 * 1024 / 4; const f32x4* s4 = (const f32x4*)tmp; f32x4* d4 = (f32x4*)dst;
    for (size_t i = (size_t)BID() * 512 + TID(); i < n4; i += (size_t)GDIM() * 512) d4[i] = s4[i];
}
__device__ __forceinline__ void conv8(const bf16_t* src, int ld, int tl, const float* w, int wld, const float* bias, float* out) {
    { const f32x4 b0 = *(const f32x4*)bias, b1 = *(const f32x4*)(bias + 4);
#pragma unroll
      for (int e = 0; e < 4; ++e) { out[e] = b0[e]; out[4 + e] = b1[e]; } }
#pragma unroll
    for (int k = 0; k < 4; ++k) if (tl - 3 + k >= 0) { const u32x4 r = *(const u32x4*)(src + (long)(k - 3) * ld); float v[8]; UNPACK8(r, v);
        const f32x4 w0 = *(const f32x4*)(w + k * wld), w1 = *(const f32x4*)(w + k * wld + 4);
#pragma unroll
        for (int e = 0; e < 4; ++e) { out[e] += w0[e] * v[e]; out[4 + e] += w1[e] * v[4 + e]; } }
}
__device__ __forceinline__ void conv8_load(const bf16_t* src, int ld, int tl, u32x4* r) {
#pragma unroll
    for (int k = 0; k < 4; ++k) { r[k] = (u32x4){0u, 0u, 0u, 0u}; if (tl - 3 + k >= 0) r[k] = *(const u32x4*)(src + (long)(k - 3) * ld); }
}
__device__ __forceinline__ void conv8_calc(const u32x4* r, const float* w, int wld, const float* bias, float* out) {
    { const f32x4 b0 = *(const f32x4*)bias, b1 = *(const f32x4*)(bias + 4);
#pragma unroll
      for (int e = 0; e < 4; ++e) { out[e] = b0[e]; out[4 + e] = b1[e]; } }
#pragma unroll
    for (int k = 0; k < 4; ++k) { float v[8]; UNPACK8(r[k], v);
        const f32x4 w0 = *(const f32x4*)(w + k * wld), w1 = *(const f32x4*)(w + k * wld + 4);
#pragma unroll
        for (int e = 0; e < 4; ++e) { out[e] += w0[e] * v[e]; out[4 + e] += w1[e] * v[4 + e]; } }
}
__device__ __forceinline__ void phase_lru_conv(const Params& p) {
    const bf16_t* proj = (const bf16_t*)(p.ws + A_PROJ); bf16_t* xc = (bf16_t*)(p.ws + A_H);
    const int oct = TID() & 127, sub = TID() >> 7;
    for (int t = BID() * 4 + sub; t < T_TOK; t += GDIM() * 4) {
        float o[8]; conv8(proj + (size_t)t * PROJ_LD + 2048 + oct * 8, PROJ_LD, t & (SEQL - 1), p.in[10] + oct * 8, 1024, p.in[11] + oct * 8, o);
        *(u32x4*)(xc + (size_t)t * 1024 + oct * 8) = PACK8(o);
    }
}
__device__ __forceinline__ void phase_lru_agg(const Params& p) {
    bf16_t* proj = (bf16_t*)(p.ws + A_PROJ); float* agg = (float*)(p.ws + A_ST); const float* rstd = (const float*)(p.ws + S_RSTD); const float* gn = p.in[22];
    const int ch = TID() * 2;
    for (int u = BID(); u < 512; u += GDIM()) {
        const int t0 = u * 64; float h0 = 0.f, h1 = 0.f, l0 = 0.f, l1 = 0.f;
        const f32x2 gg = *(const f32x2*)(gn + ch); const int grp = ch >> 9;
#pragma unroll 1
        for (int lb = 0; lb < 64; lb += 8) { unsigned la[8], uu[8], yy[8]; float rs[8];
#pragma unroll
            for (int i = 0; i < 8; ++i) { const bf16_t* row = proj + (size_t)(t0 + lb + i) * PROJ_LD; la[i] = *(const unsigned*)(row + 3072 + ch); uu[i] = *(const unsigned*)(row + 2048 + ch);
                yy[i] = *(const unsigned*)(row + 1024 + ch); rs[i] = rstd[(size_t)(t0 + lb + i) * 2 + grp]; }
#pragma unroll
            for (int i = 0; i < 8; ++i) { const float la0 = __uint_as_float(la[i] << 16), la1 = __uint_as_float(la[i] & 0xffff0000u);
                h0 = __expf(la0) * h0 + __uint_as_float(uu[i] << 16); h1 = __expf(la1) * h1 + __uint_as_float(uu[i] & 0xffff0000u); l0 += la0; l1 += la1;
                *(unsigned*)(proj + (size_t)(t0 + lb + i) * PROJ_LD + 1024 + ch) = pk2(__uint_as_float(yy[i] << 16) * rs[i] * gg.x, __uint_as_float(yy[i] & 0xffff0000u) * rs[i] * gg.y); } }
        float* a = agg + (size_t)u * 2048 + ch * 2; *(f32x4*)a = (f32x4){l0, h0, l1, h1};
    }
}
__device__ __forceinline__ void phase_lru_final(const Params& p) {
    bf16_t* proj = (bf16_t*)(p.ws + A_PROJ); const float* agg = (const float*)(p.ws + A_ST);
    const int ch = TID() * 2;
    for (int u = BID(); u < 512; u += GDIM()) {
        const int bq = u >> 7, cr = u & 127, c = (bq & 2) ? 127 - cr : cr, ub = bq * 128, t0 = (ub + c) * 64; float h0 = 0.f, h1 = 0.f;
        int j = 0;
#pragma unroll 1
        for (; j + 8 <= c; j += 8) { f32x4 a[8];
#pragma unroll
            for (int i = 0; i < 8; ++i) a[i] = *(const f32x4*)(agg + (size_t)(ub + j + i) * 2048 + ch * 2);
#pragma unroll
            for (int i = 0; i < 8; ++i) { h0 = __expf(a[i][0]) * h0 + a[i][1]; h1 = __expf(a[i][2]) * h1 + a[i][3]; } }
        for (; j < c; ++j) { const f32x4 a = *(const f32x4*)(agg + (size_t)(ub + j) * 2048 + ch * 2); h0 = __expf(a[0]) * h0 + a[1]; h1 = __expf(a[2]) * h1 + a[3]; }
#pragma unroll 1
        for (int lb = 0; lb < 64; lb += 8) { unsigned la[8], uu[8], gt[8];
#pragma unroll
            for (int i = 0; i < 8; ++i) { const bf16_t* row = proj + (size_t)(t0 + lb + i) * PROJ_LD; la[i] = *(const unsigned*)(row + 3072 + ch); uu[i] = *(const unsigned*)(row + 2048 + ch); gt[i] = *(const unsigned*)(row + ch); }
#pragma unroll
            for (int i = 0; i < 8; ++i) { h0 = __expf(__uint_as_float(la[i] << 16)) * h0 + __uint_as_float(uu[i] << 16); h1 = __expf(__uint_as_float(la[i] & 0xffff0000u)) * h1 + __uint_as_float(uu[i] & 0xffff0000u);
                *(unsigned*)(proj + (size_t)(t0 + lb + i) * PROJ_LD + ch) = pk2(h0 * gelu_tanh(__uint_as_float(gt[i] << 16)), h1 * gelu_tanh(__uint_as_float(gt[i] & 0xffff0000u))); } }
    }
}
__device__ __forceinline__ void phase_ssd_rec(const Params& p) {
    bf16_t* st = (bf16_t*)(p.ws + A_ST); const float* chtot = (const float*)(p.ws + S_CHTOT);
    for (int idx = BID() * 512 + TID(); idx < 131072; idx += GDIM() * 512) {
        const int n4 = idx & 31, pp = (idx >> 5) & 63, hh = (idx >> 11) & 15, b = idx >> 15;
        float r0 = 0.f, r1 = 0.f, r2 = 0.f, r3 = 0.f;
        bf16_t* base = st + ((size_t)(b * 64 * 16 + hh) * 64 + pp) * 128 + n4 * 4; const size_t cstride = (size_t)16 * 64 * 128;
#pragma unroll 1
        for (int c0 = 0; c0 < 64; c0 += 8) { u32x2 sv[8]; float dv[8];
#pragma unroll
            for (int i = 0; i < 8; ++i) { sv[i] = *(const u32x2*)(base + (size_t)(c0 + i) * cstride); dv[i] = chtot[(b * 64 + c0 + i) * 16 + hh]; }
#pragma unroll
            for (int i = 0; i < 8; ++i) { const float d = __expf(dv[i]);
                u32x2 w; w.x = pk2(r0, r1); w.y = pk2(r2, r3); *(u32x2*)(base + (size_t)(c0 + i) * cstride) = w;
                r0 = r0 * d + __uint_as_float(sv[i].x << 16); r1 = r1 * d + __uint_as_float(sv[i].x & 0xffff0000u); r2 = r2 * d + __uint_as_float(sv[i].y << 16); r3 = r3 * d + __uint_as_float(sv[i].y & 0xffff0000u); } }
    }
}
#define MFMA16(x, y, acc) __builtin_amdgcn_mfma_f32_16x16x32_bf16((x), (y), (acc), 0, 0, 0)
__device__ __forceinline__ bf16_t bf1(float v) { return (bf16_t)(pk2(v, 0.f) & 0xffffu); }
__device__ __forceinline__ void ssd_dt_scan(const Params& p, int b, int c, int g, float* dtv, float* acs, bool write_tot) {
    const int w = TID() >> 6, lane = TID() & 63, hh = g * 8 + w;
    const float a = -__expf(p.in[20][hh]), bias = p.in[19][hh]; const float* dt = (const float*)(p.ws + A_DT);
    const size_t t0 = (size_t)b * SEQL + c * 128;
    const float d0 = softplusf(dt[(t0 + lane) * 16 + hh] + bias), d1 = softplusf(dt[(t0 + 64 + lane) * 16 + hh] + bias);
    float v0 = d0 * a, v1 = d1 * a;
#pragma unroll
    for (int o = 1; o < 64; o <<= 1) { const float t0v = __shfl_up(v0, o), t1v = __shfl_up(v1, o); if (lane >= o) { v0 += t0v; v1 += t1v; } }
    v1 += __shfl(v0, 63);
    dtv[w * 128 + lane] = d0; dtv[w * 128 + 64 + lane] = d1; acs[w * 128 + lane] = v0; acs[w * 128 + 64 + lane] = v1;
    if (write_tot && lane == 63) ((float*)(p.ws + S_CHTOT))[(b * 64 + c) * 16 + hh] = v1;
}
__device__ __forceinline__ void ssd_pass1_unit(const Params& p, int unit, unsigned char* sm) {
    const int g = unit & 1, c = (unit >> 1) & 63, b = unit >> 7;
    bf16_t* BT = (bf16_t*)sm; bf16_t* xT = (bf16_t*)(sm + 34816); float* dtv = (float*)(sm + 52224); float* acs = (float*)(sm + 56320);
    const int tid = TID(), w = tid >> 6, lane = tid & 63, fr = lane & 15, fq = lane >> 4;
    const bf16_t* proj = (const bf16_t*)(p.ws + A_PROJ); bf16_t* st = (bf16_t*)(p.ws + A_ST);
    const size_t t0 = (size_t)b * SEQL + c * 128; const int tl0 = c * 128;
    const float* cw = p.in[17]; const float* cbi = p.in[18];
    ssd_dt_scan(p, b, c, g, dtv, acs, true);
#pragma unroll 1
    for (int i = 0; i < 4; ++i) { const int l = (tid >> 4) + 32 * i, oct = tid & 15, ch = 1024 + g * 128 + oct * 8; float o[8];
        conv8(proj + (t0 + l) * PROJ_LD + 3072 + ch, PROJ_LD, tl0 + l, cw + ch, 1536, cbi + ch, o);
#pragma unroll
        for (int e = 0; e < 8; ++e) BT[(oct * 8 + e) * 136 + l] = bf1(siluf(o[e])); }
    __syncthreads();
    const int xl = tid >> 3, xo = tid & 7;
    u32x4 xr[2][4];
#pragma unroll
    for (int i = 0; i < 2; ++i) conv8_load(proj + (t0 + xl + 64 * i) * PROJ_LD + 3072 + g * 512 + xo * 8, PROJ_LD, tl0 + xl + 64 * i, xr[i]);
#pragma unroll 1
    for (int hi = 0; hi < 8; ++hi) { const int hh = g * 8 + hi;
#pragma unroll
        for (int i = 0; i < 2; ++i) { const int l = xl + 64 * i, ch = hh * 64 + xo * 8; float o[8];
            conv8_calc(xr[i], cw + ch, 1536, cbi + ch, o);
            const float sc = dtv[hi * 128 + l] * __expf(acs[hi * 128 + 127] - acs[hi * 128 + l]);
#pragma unroll
            for (int e = 0; e < 8; ++e) xT[(xo * 8 + e) * 136 + l] = bf1(siluf(o[e]) * sc); }
        __syncthreads();
        if (hi < 7) {
#pragma unroll
            for (int i = 0; i < 2; ++i) conv8_load(proj + (t0 + xl + 64 * i) * PROJ_LD + 3072 + (hh + 1) * 64 + xo * 8, PROJ_LD, tl0 + xl + 64 * i, xr[i]); }
        const int pt = w & 3, nt0 = (w >> 2) * 4;
        f32x4 acc[4];
#pragma unroll
        for (int q = 0; q < 4; ++q) acc[q] = (f32x4){0.f, 0.f, 0.f, 0.f};
#pragma unroll
        for (int ks = 0; ks < 4; ++ks) { const bf16x8 y = *(const bf16x8*)(xT + (16 * pt + fr) * 136 + ks * 32 + fq * 8);
#pragma unroll
            for (int q = 0; q < 4; ++q) { const bf16x8 x = *(const bf16x8*)(BT + (16 * (nt0 + q) + fr) * 136 + ks * 32 + fq * 8); acc[q] = MFMA16(x, y, acc[q]); } }
        bf16_t* so = st + ((size_t)((b * 64 + c) * 16 + hh) * 64 + 16 * pt + fr) * 128;
#pragma unroll
        for (int q = 0; q < 4; ++q) { u32x2 wv; wv.x = pk2(acc[q][0], acc[q][1]); wv.y = pk2(acc[q][2], acc[q][3]); *(u32x2*)(so + 16 * (nt0 + q) + 4 * fq) = wv; }
        __syncthreads();
    }
}
__device__ __forceinline__ void ssd_pass3_unit(const Params& p, int unit, unsigned char* sm) {
    const int g = unit & 1, c = (unit >> 1) & 63, b = unit >> 7;
    const int tid = TID(), w = tid >> 6, lane = tid & 63, fr = lane & 15, fq = lane >> 4;
    bf16_t* Cs = (bf16_t*)sm; bf16_t* Bs = (bf16_t*)(sm + 34816); bf16_t* xT0 = (bf16_t*)(sm + 69632); bf16_t* Pw = (bf16_t*)(sm + 104448 + w * 4352);
    float* dtv = (float*)(sm + 139264); float* acs = (float*)(sm + 143360);
    bf16_t* proj = (bf16_t*)(p.ws + A_PROJ); const bf16_t* st = (const bf16_t*)(p.ws + A_ST);
    const size_t t0 = (size_t)b * SEQL + c * 128; const int tl0 = c * 128;
    const float* cw = p.in[17]; const float* cbi = p.in[18];
    ssd_dt_scan(p, b, c, g, dtv, acs, false);
#pragma unroll 1
    for (int i = 0; i < 8; ++i) { const int item = tid + 512 * i, arr = item >> 11, l = (item >> 4) & 127, oct = item & 15, ch = 1024 + arr * 256 + g * 128 + oct * 8; float o[8];
        conv8(proj + (t0 + l) * PROJ_LD + 3072 + ch, PROJ_LD, tl0 + l, cw + ch, 1536, cbi + ch, o);
#pragma unroll
        for (int e = 0; e < 8; ++e) o[e] = siluf(o[e]);
        *(u32x4*)((arr ? Cs : Bs) + l * 136 + oct * 8) = PACK8(o); }
    __syncthreads();
    const int l0 = 16 * w, l = l0 + fr; const size_t trow = t0 + l;
    bf16x8 cf[4];
#pragma unroll
    for (int ks = 0; ks < 4; ++ks) cf[ks] = *(const bf16x8*)(Cs + (l0 + fr) * 136 + ks * 32 + fq * 8);
    f32x4 cb[8];
#pragma unroll
    for (int nt = 0; nt < 8; ++nt) { cb[nt] = (f32x4){0.f, 0.f, 0.f, 0.f};
#pragma unroll
        for (int ks = 0; ks < 4; ++ks) { const bf16x8 x = *(const bf16x8*)(Bs + (16 * nt + fr) * 136 + ks * 32 + fq * 8); cb[nt] = MFMA16(x, cf[ks], cb[nt]); } }
    float ss = 0.f;
    const int xl = tid >> 3, xo = tid & 7;
    u32x4 xr[2][4];
#pragma unroll
    for (int i = 0; i < 2; ++i) conv8_load(proj + (t0 + xl + 64 * i) * PROJ_LD + 3072 + g * 512 + xo * 8, PROJ_LD, tl0 + xl + 64 * i, xr[i]);
#pragma unroll 1
    for (int hi = 0; hi < 8; ++hi) { const int hh = g * 8 + hi; bf16_t* xT = xT0 + (hi & 1) * 8704;
        const bf16_t* prev = st + (size_t)((b * 64 + c) * 16 + hh) * 64 * 128;
        bf16x8 pf[4][4]; u32x2 zr[4];
#pragma unroll
        for (int ks = 0; ks < 4; ++ks)
#pragma unroll
            for (int pt = 0; pt < 4; ++pt) pf[ks][pt] = *(const bf16x8*)(prev + (size_t)(16 * pt + fr) * 128 + ks * 32 + fq * 8);
#pragma unroll
        for (int pt = 0; pt < 4; ++pt) zr[pt] = *(const u32x2*)(proj + trow * PROJ_LD + 1024 + hh * 64 + 16 * pt + 4 * fq);
#pragma unroll
        for (int i = 0; i < 2; ++i) { const int l_ = xl + 64 * i, ch = hh * 64 + xo * 8; float o[8];
            conv8_calc(xr[i], cw + ch, 1536, cbi + ch, o);
#pragma unroll
            for (int e = 0; e < 8; ++e) xT[(xo * 8 + e) * 136 + l_] = bf1(siluf(o[e])); }
        const float al = acs[hi * 128 + l];
#pragma unroll
        for (int nt = 0; nt < 8; ++nt) { float v[4]; const f32x4 a4 = *(const f32x4*)(acs + hi * 128 + 16 * nt + 4 * fq), d4 = *(const f32x4*)(dtv + hi * 128 + 16 * nt + 4 * fq);
#pragma unroll
            for (int j = 0; j < 4; ++j) { const int s = 16 * nt + 4 * fq + j; v[j] = (s <= l) ? cb[nt][j] * __expf(al - a4[j]) * d4[j] : 0.f; }
            u32x2 wv; wv.x = pk2(v[0], v[1]); wv.y = pk2(v[2], v[3]); *(u32x2*)(Pw + fr * 136 + 16 * nt + 4 * fq) = wv; }
        __syncthreads();
        if (hi < 7) {
#pragma unroll
            for (int i = 0; i < 2; ++i) conv8_load(proj + (t0 + xl + 64 * i) * PROJ_LD + 3072 + (hh + 1) * 64 + xo * 8, PROJ_LD, tl0 + xl + 64 * i, xr[i]); }
        f32x4 yd[4], yo[4];
#pragma unroll
        for (int pt = 0; pt < 4; ++pt) { yd[pt] = (f32x4){0.f, 0.f, 0.f, 0.f}; yo[pt] = (f32x4){0.f, 0.f, 0.f, 0.f}; }
#pragma unroll
        for (int ks = 0; ks < 4; ++ks) { const bf16x8 yf = *(const bf16x8*)(Pw + fr * 136 + ks * 32 + fq * 8);
#pragma unroll
            for (int pt = 0; pt < 4; ++pt) { const bf16x8 x = *(const bf16x8*)(xT + (16 * pt + fr) * 136 + ks * 32 + fq * 8); yd[pt] = MFMA16(x, yf, yd[pt]);
                yo[pt] = MFMA16(pf[ks][pt], cf[ks], yo[pt]); } }
        const float ea = __expf(al), Dh = p.in[21][hh];
#pragma unroll
        for (int pt = 0; pt < 4; ++pt) { const int pp = 16 * pt + 4 * fq; bf16_t* za = proj + trow * PROJ_LD + 1024 + hh * 64 + pp;
            float zv[4] = {__uint_as_float(zr[pt].x << 16), __uint_as_float(zr[pt].x & 0xffff0000u), __uint_as_float(zr[pt].y << 16), __uint_as_float(zr[pt].y & 0xffff0000u)}; float y[4];
#pragma unroll
            for (int j = 0; j < 4; ++j) { const float xv = bf2f(xT[(pp + j) * 136 + l]); y[j] = (yd[pt][j] + ea * yo[pt][j] + Dh * xv) * siluf(zv[j]); ss += y[j] * y[j]; }
            u32x2 wv; wv.x = pk2(y[0], y[1]); wv.y = pk2(y[2], y[3]); *(u32x2*)za = wv; }
    }
    ss += __shfl_xor(ss, 16); ss += __shfl_xor(ss, 32);
    if (fq == 0) ((float*)(p.ws + S_RSTD))[trow * 2 + g] = rsqrtf(ss * (1.0f / 512.0f) + 1e-6f);
    __syncthreads();
}
__device__ __forceinline__ void phase_ml_conv(const Params& p) {
    const bf16_t* up = (const bf16_t*)(p.ws + A_PROJ); bf16_t* xc = (bf16_t*)(p.ws + A_XC); float* gp = (float*)(p.ws + A_GP); const float* weff = (const float*)(p.ws + S_WEFF);
    const int tid = TID(), oct = tid & 255, sub = tid >> 8, ch = oct * 8, lane = tid & 63, wq4 = (tid >> 6) & 3;
    float cw[4][8], cbv[8]; f32x2 wc[8][4], wm[8][4];
#pragma unroll
    for (int e = 0; e < 8; ++e) { cbv[e] = p.in[25][ch + e];
#pragma unroll
        for (int k = 0; k < 4; ++k) cw[k][e] = p.in[24][k * 2048 + ch + e];
#pragma unroll
        for (int g = 0; g < 4; ++g) { wc[e][g] = *(const f32x2*)(weff + (size_t)(ch + e) * 8 + 2 * g); wm[e][g] = *(const f32x2*)(weff + (size_t)(2048 + ch + e) * 8 + 2 * g); } }
    const int nstream = GDIM() * 2, len = T_TOK / nstream; int t = (BID() * 2 + sub) * len;
    float x0[8], x1[8], x2[8];
    { const int tl = t & (SEQL - 1); u32x4 r;
      if (tl >= 3) { r = *(const u32x4*)(up + (size_t)(t - 3) * 4096 + ch); UNPACK8(r, x0); } else {
#pragma unroll
          for (int e = 0; e < 8; ++e) x0[e] = 0.f; }
      if (tl >= 2) { r = *(const u32x4*)(up + (size_t)(t - 2) * 4096 + ch); UNPACK8(r, x1); } else {
#pragma unroll
          for (int e = 0; e < 8; ++e) x1[e] = 0.f; }
      if (tl >= 1) { r = *(const u32x4*)(up + (size_t)(t - 1) * 4096 + ch); UNPACK8(r, x2); } else {
#pragma unroll
          for (int e = 0; e < 8; ++e) x2[e] = 0.f; } }
    u32x4 nxt = *(const u32x4*)(up + (size_t)t * 4096 + ch);
    const bool lo32 = lane < 32, b16 = ((lane >> 4) & 1) == 0, b8 = ((lane >> 3) & 1) == 0;
    const int gidx = (lo32 ? 0 : 4) + (b16 ? 0 : 2) + (b8 ? 0 : 1);
#pragma unroll 1
    for (int i = 0; i < len; ++i, ++t) {
        if (i > 0 && (t & (SEQL - 1)) == 0) {
#pragma unroll
            for (int e = 0; e < 8; ++e) { x0[e] = 0.f; x1[e] = 0.f; x2[e] = 0.f; } }
        const u32x4 cur = nxt; if (i + 1 < len) nxt = *(const u32x4*)(up + (size_t)(t + 1) * 4096 + ch);
        float xm[8], o[8]; UNPACK8(cur, xm);
#pragma unroll
        for (int e = 0; e < 8; ++e) o[e] = siluf(cbv[e] + cw[0][e] * x0[e] + cw[1][e] * x1[e] + cw[2][e] * x2[e] + cw[3][e] * xm[e]);
        *(u32x4*)(xc + (size_t)t * 2048 + ch) = PACK8(o);
        float gs[8];
#pragma unroll
        for (int g = 0; g < 4; ++g) { f32x2 a = (f32x2){0.f, 0.f};
#pragma unroll
            for (int e = 0; e < 8; ++e) { a += wc[e][g] * o[e]; a += wm[e][g] * xm[e]; }
            gs[2 * g] = a.x; gs[2 * g + 1] = a.y; }
        float k4[4], k2[2], k1;
#pragma unroll
        for (int q = 0; q < 4; ++q) { const float snd = lo32 ? gs[4 + q] : gs[q]; const float rcv = __shfl_xor(snd, 32); k4[q] = (lo32 ? gs[q] : gs[4 + q]) + rcv; }
#pragma unroll
        for (int q = 0; q < 2; ++q) { const float snd = b16 ? k4[2 + q] : k4[q]; const float rcv = __shfl_xor(snd, 16); k2[q] = (b16 ? k4[q] : k4[2 + q]) + rcv; }
        { const float snd = b8 ? k2[1] : k2[0]; const float rcv = __shfl_xor(snd, 8); k1 = (b8 ? k2[0] : k2[1]) + rcv; }
        k1 += __shfl_xor(k1, 4); k1 += __shfl_xor(k1, 2); k1 += __shfl_xor(k1, 1);
        if ((lane & 7) == 0) gp[((size_t)t * 4 + wq4) * 8 + gidx] = k1;
#pragma unroll
        for (int e = 0; e < 8; ++e) { x0[e] = x1[e]; x1[e] = x2[e]; x2[e] = xm[e]; }
    }
}
__device__ __forceinline__ bf16x8 bd8(const u32x4 r, const float* wl, int blk0) {
    float v[8], q[8]; UNPACK8(r, v);
#pragma unroll
    for (int bb = 0; bb < 2; ++bb) { const float* wb = wl + (blk0 + bb) * 16;
        const f32x4 w0 = *(const f32x4*)(wb), w1 = *(const f32x4*)(wb + 4), w2 = *(const f32x4*)(wb + 8), w3 = *(const f32x4*)(wb + 12);
#pragma unroll
        for (int o = 0; o < 4; ++o) q[4 * bb + o] = v[4 * bb] * w0[o] + v[4 * bb + 1] * w1[o] + v[4 * bb + 2] * w2[o] + v[4 * bb + 3] * w3[o]; }
    const u32x4 pk = PACK8(q); return __builtin_bit_cast(bf16x8, pk);
}
__device__ __forceinline__ void phase_ml_intra(const Params& p, unsigned char* sm) {
    const int tid = TID(), w = tid >> 6, lane = tid & 63, fr = lane & 15, fq = lane >> 4;
    bf16_t* ksm = (bf16_t*)sm; float* wql = (float*)(sm + 66560); float* wkl = (float*)(sm + 74752); float* bc = (float*)(sm + 82944); float* ig = (float*)(sm + 83200); float* rs = (float*)(sm + 83456);
    const bf16_t* xc = (const bf16_t*)(p.ws + A_XC); const float* gp = (const float*)(p.ws + A_GP);
    int curh = -1;
    const int ks_s = tid >> 3, ks_o = tid & 7;
    u32x4 kr[8];
    { const int it0 = BID(); if (it0 < 2048) { const int h0 = it0 & 3, j0 = it0 >> 2; const size_t tt0 = (size_t)(j0 >> 7) * SEQL + (j0 & 127) * 64;
        const bf16_t* src = xc + (tt0 + ks_s) * 2048 + h0 * 512 + ks_o * 8;
#pragma unroll
        for (int i = 0; i < 8; ++i) kr[i] = *(const u32x4*)(src + i * 64); } }
    for (int it = BID(); it < 2048; it += GDIM()) {
        const int h = it & 3, j = it >> 2, bq = j >> 7, c = j & 127, unit = (bq * 4 + h) * 128 + c;
        float* aux = (float*)(p.ws + A_AUX) + (size_t)unit * 256; bf16_t* si = (bf16_t*)(p.ws + A_SI) + (size_t)unit * 4096;
        const size_t t0 = (size_t)bq * SEQL + c * 64;
        if (h != curh) { __syncthreads(); const float* gq = (const float*)(p.ws + S_GQK) + h * 2048;
            for (int i = tid; i < 2048; i += 512) { const int blk = i >> 4, ii = (i >> 2) & 3, oo = i & 3; wkl[i] = gq[blk * 16 + oo * 4 + ii]; } curh = h; __syncthreads(); }
#pragma unroll
        for (int i = 0; i < 8; ++i) *(bf16x8*)(ksm + ks_s * 520 + (ks_o + 8 * i) * 8) = bd8(kr[i], wkl, (ks_o + 8 * i) * 2);
        if (w == 0) { const float* g0 = gp + (t0 + lane) * 32; float ip = p.in[30][h], fp = p.in[30][4 + h];
#pragma unroll
            for (int q = 0; q < 4; ++q) { ip += g0[q * 8 + h]; fp += g0[q * 8 + 4 + h]; }
            float v = -softplusf(-fp);
#pragma unroll
            for (int o = 1; o < 64; o <<= 1) { const float tv = __shfl_up(v, o); if (lane >= o) v += tv; }
            const float bl = __shfl(v, 63);
            bc[lane] = v; ig[lane] = ip; aux[lane] = __expf(v); aux[64 + lane] = __expf(bl - v + ip); if (lane == 0) aux[192] = __expf(bl); }
        __syncthreads();
        { const int itn = it + GDIM(); if (itn < 2048) { const int hn = itn & 3, jn = itn >> 2; const size_t ttn = (size_t)(jn >> 7) * SEQL + (jn & 127) * 64;
            const bf16_t* src = xc + (ttn + ks_s) * 2048 + hn * 512 + ks_o * 8;
#pragma unroll
            for (int i = 0; i < 8; ++i) kr[i] = *(const u32x4*)(src + i * 64); } }
        const int mt = w >> 1, nt0 = (w & 1) * 2;
        f32x4 acc[2]; acc[0] = (f32x4){0.f, 0.f, 0.f, 0.f}; acc[1] = acc[0];
        if (nt0 <= mt) {
            const bf16_t* xq = xc + (t0 + 16 * mt + fr) * 2048 + h * 512 + fq * 8;
            u32x4 qr[16];
#pragma unroll
            for (int ks = 0; ks < 16; ++ks) qr[ks] = *(const u32x4*)(xq + ks * 32);
#pragma unroll
            for (int ks = 0; ks < 16; ++ks) { const bf16x8 yq = __builtin_bit_cast(bf16x8, qr[ks]);
                const bf16x8 k0 = *(const bf16x8*)(ksm + (16 * nt0 + fr) * 520 + ks * 32 + fq * 8), k1 = *(const bf16x8*)(ksm + (16 * nt0 + 16 + fr) * 520 + ks * 32 + fq * 8);
                acc[0] = MFMA16(k0, yq, acc[0]); acc[1] = MFMA16(k1, yq, acc[1]); } }
        const int t = 16 * mt + fr; const float bt = bc[t]; float rsum = 0.f;
#pragma unroll
        for (int q = 0; q < 2; ++q) { float v[4];
#pragma unroll
            for (int jj = 0; jj < 4; ++jj) { const int s = 16 * (nt0 + q) + 4 * fq + jj; v[jj] = (s <= t) ? acc[q][jj] * __expf(bt - bc[s] + ig[s]) : 0.f; rsum += v[jj]; }
            u32x2 wv; wv.x = pk2(v[0], v[1]); wv.y = pk2(v[2], v[3]); *(u32x2*)(si + t * 64 + 16 * (nt0 + q) + 4 * fq) = wv; }
        rsum += __shfl_xor(rsum, 16); rsum += __shfl_xor(rsum, 32);
        if (fq == 0) rs[(w & 1) * 64 + t] = rsum;
        __syncthreads();
        if (tid < 64) aux[128 + tid] = rs[tid] + rs[64 + tid];
        __syncthreads();
    }
}
typedef short s16x4 __attribute__((ext_vector_type(4)));
__device__ __forceinline__ bf16x8 tr_frag(LAS unsigned char* a) {
    const s16x4 lo = __builtin_amdgcn_ds_read_tr16_b64_v4i16((LAS s16x4*)a), hi = __builtin_amdgcn_ds_read_tr16_b64_v4i16((LAS s16x4*)(a + 4 * 1040));
    return (bf16x8){lo[0], lo[1], lo[2], lo[3], hi[0], hi[1], hi[2], hi[3]};
}
__device__ __forceinline__ void ml_seq_item(const Params& p, int item, unsigned char* sm, LAS unsigned char* lds) {
    const int bh = (item & 7) * 2 + ((item >> 3) & 1), slice = item >> 4, h = bh & 3, b = bh >> 2, vcol0 = h * 512 + slice * 32;
    const int tid = TID(), w = tid >> 6, lane = tid & 63, fr = lane & 15, fq = lane >> 4;
    bf16_t* xcN = (bf16_t*)sm; bf16_t* MT0 = (bf16_t*)(sm + 66560); bf16_t* nrow0 = (bf16_t*)(sm + 133120); bf16_t* vT = (bf16_t*)(sm + 135296); bf16_t* vwT = (bf16_t*)(sm + 139904);
    float* G = (float*)(sm + 144512); float* scl = (float*)(sm + 152704); bf16_t* wsb = (bf16_t*)(sm + 153728);
    const bf16_t* xc = (const bf16_t*)(p.ws + A_XC); bf16_t* up = (bf16_t*)(p.ws + A_PROJ); const float* auxb = (const float*)(p.ws + A_AUX); const bf16_t* sib = (const bf16_t*)(p.ws + A_SI);
    for (int i = tid; i < 32 * 520; i += 512) ((unsigned*)MT0)[i] = 0u;
    for (int i = tid; i < 544; i += 512) ((unsigned*)nrow0)[i] = 0u;
    for (int i = tid; i < 2048; i += 512) G[i] = ((const float*)(p.ws + S_GQK))[h * 2048 + i];
    f32x4 M[4][2], N[4];
#pragma unroll
    for (int q = 0; q < 4; ++q) { M[q][0] = (f32x4){0.f, 0.f, 0.f, 0.f}; M[q][1] = M[q][0]; N[q] = M[q][0]; }
    float* wvl = (float*)(sm + 153984);
    if (tid < 128) wvl[tid] = p.in[28][(size_t)(vcol0 >> 2) * 16 + tid];
    const int vs = tid >> 3, vb = tid & 7;
    const int trB = 32 * (w & 1) + fr, vtB = (w >> 1) & 1;
    LAS unsigned char* trbase = lds + (size_t)((fq * 8 + (fr >> 2)) * 520 + 4 * (fr & 3)) * 2;
    u32x4 stg[8]; u32x4 sreg; u32x2 vraw; float auxv, wsv;
    bf16_t* ssm = (bf16_t*)(sm + 154496);
#define ML_ISSUE(cc) do { const int unit_ = bh * 128 + (cc); const size_t t0_ = (size_t)b * SEQL + (size_t)(cc) * 64; const float* aux_ = auxb + (size_t)unit_ * 256; \
        auxv = aux_[tid & 255]; wsv = aux_[64 + vs]; \
        { const bf16_t* s_ = xc + (t0_ + vs) * 2048 + h * 512 + vb * 8; _Pragma("unroll") for (int i_ = 0; i_ < 8; ++i_) stg[i_] = *(const u32x4*)(s_ + i_ * 64); } \
        vraw = *(const u32x2*)(up + (t0_ + vs) * 4096 + vcol0 + 4 * vb); \
        sreg = *(const u32x4*)(sib + (size_t)unit_ * 4096 + tid * 8); \
        } while (0)
#define LBAR() do { asm volatile("s_waitcnt lgkmcnt(0)" ::: "memory"); __builtin_amdgcn_s_barrier(); asm volatile("" ::: "memory"); } while (0)
    ML_ISSUE(0);
    __syncthreads();
    bf16x8 Xg[4];
#pragma unroll
    for (int q = 0; q < 4; ++q) { const float* Gb = G + (4 * (4 * w + q) + (fr >> 2)) * 16 + (fr & 3) * 4; const bool on = (fq == (fr >> 2));
        const unsigned p0 = on ? pk2(Gb[0], Gb[1]) : 0u, p1 = on ? pk2(Gb[2], Gb[3]) : 0u; const u32x4 pk = (u32x4){p0, p1, 0u, 0u}; Xg[q] = __builtin_bit_cast(bf16x8, pk); }
#pragma unroll 1
    for (int c = 0; c < 128; ++c) {
        const size_t t0 = (size_t)b * SEQL + c * 64;
        bf16_t* MTc = MT0 + (c & 1) * (32 * 520); bf16_t* MTn = MT0 + ((c + 1) & 1) * (32 * 520); bf16_t* nrc = nrow0 + (c & 1) * 544; bf16_t* nrn = nrow0 + ((c + 1) & 1) * 544;
        if (tid < 256) scl[tid] = auxv;
        if (tid >= 64 && tid < 128) wsb[tid - 64] = bf1(auxv);
        *(u32x4*)(ssm + vs * 72 + vb * 8) = sreg;
#pragma unroll
        for (int i = 0; i < 8; ++i) *(u32x4*)(xcN + vs * 520 + (vb + 8 * i) * 8) = stg[i];
        { const float x0 = __uint_as_float(vraw.x << 16), x1 = __uint_as_float(vraw.x & 0xffff0000u), x2 = __uint_as_float(vraw.y << 16), x3 = __uint_as_float(vraw.y & 0xffff0000u);
          const f32x4 w0 = *(const f32x4*)(wvl + vb * 16), w1 = *(const f32x4*)(wvl + vb * 16 + 4), w2 = *(const f32x4*)(wvl + vb * 16 + 8), w3 = *(const f32x4*)(wvl + vb * 16 + 12);
#pragma unroll
          for (int o = 0; o < 4; ++o) { const float v = x0 * w0[o] + x1 * w1[o] + x2 * w2[o] + x3 * w3[o]; vT[(4 * vb + o) * 72 + vs] = bf1(v); vwT[(4 * vb + o) * 72 + vs] = bf1(v * wsv); } }
        LBAR();
        if (c + 1 < 128) ML_ISSUE(c + 1);
        if (w < 4) {
          f32x4 ai[2], aa[2], aq[2];
#pragma unroll
          for (int a = 0; a < 2; ++a) { aq[a] = (f32x4){0.f, 0.f, 0.f, 0.f}; ai[a] = aq[a]; aa[a] = aq[a]; }
#pragma unroll 2
          for (int ks = 0; ks < 16; ++ks) { const bf16x8 y0 = *(const bf16x8*)(xcN + trB * 520 + ks * 32 + fq * 8), y1 = *(const bf16x8*)(xcN + (trB + 16) * 520 + ks * 32 + fq * 8);
              const bf16x8 x = *(const bf16x8*)(MTc + (16 * vtB + fr) * 520 + ks * 32 + fq * 8);
              bf16x8 xn = (bf16x8){0, 0, 0, 0, 0, 0, 0, 0}; if (fr == 0) xn = *(const bf16x8*)(nrc + ks * 32 + fq * 8);
              ai[0] = MFMA16(x, y0, ai[0]); ai[1] = MFMA16(x, y1, ai[1]); aq[0] = MFMA16(xn, y0, aq[0]); aq[1] = MFMA16(xn, y1, aq[1]); }
#pragma unroll
          for (int ks = 0; ks < 2; ++ks) { const bf16x8 xv = *(const bf16x8*)(vT + (16 * vtB + fr) * 72 + ks * 32 + fq * 8);
              const bf16x8 s0 = *(const bf16x8*)(ssm + trB * 72 + ks * 32 + fq * 8), s1 = *(const bf16x8*)(ssm + (trB + 16) * 72 + ks * 32 + fq * 8);
              aa[0] = MFMA16(xv, s0, aa[0]); aa[1] = MFMA16(xv, s1, aa[1]); }
#pragma unroll
          for (int a = 0; a < 2; ++a) { const int tr = trB + 16 * a; const float qn = __shfl(aq[a][0], fr); const float eb = scl[tr];
              const float inv = __builtin_amdgcn_rcpf(fmaxf(fabsf(scl[128 + tr] + eb * qn), 1.0f));
              u32x2 wv; wv.x = pk2((aa[a][0] + eb * ai[a][0]) * inv, (aa[a][1] + eb * ai[a][1]) * inv); wv.y = pk2((aa[a][2] + eb * ai[a][2]) * inv, (aa[a][3] + eb * ai[a][3]) * inv);
              *(u32x2*)(up + (t0 + tr) * 4096 + vcol0 + 16 * vtB + 4 * fq) = wv; }
        }
        {
          const float decay = scl[192];
#pragma unroll
          for (int q = 0; q < 4; ++q) { M[q][0] *= decay; M[q][1] *= decay; N[q] *= decay; }
#pragma unroll
          for (int ks = 0; ks < 2; ++ks) { const bf16x8 y0 = *(const bf16x8*)(vwT + fr * 72 + ks * 32 + fq * 8), y1 = *(const bf16x8*)(vwT + (16 + fr) * 72 + ks * 32 + fq * 8);
              bf16x8 y2 = (bf16x8){0, 0, 0, 0, 0, 0, 0, 0}; if (fr == 0) y2 = *(const bf16x8*)(wsb + ks * 32 + fq * 8);
#pragma unroll
              for (int q = 0; q < 4; ++q) { const bf16x8 x = tr_frag(trbase + (size_t)(ks * 32 * 520 + 16 * (4 * w + q)) * 2);
                  M[q][0] = MFMA16(x, y0, M[q][0]); M[q][1] = MFMA16(x, y1, M[q][1]); N[q] = MFMA16(x, y2, N[q]); } }
#pragma unroll
          for (int q = 0; q < 4; ++q) {
#pragma unroll
              for (int v2 = 0; v2 < 3; ++v2) { const f32x4 m = (v2 == 2) ? N[q] : M[q][v2 & 1];
                  const u32x4 yk = (u32x4){pk2(m[0], m[1]), pk2(m[2], m[3]), 0u, 0u};
                  const f32x4 mt = MFMA16(Xg[q], __builtin_bit_cast(bf16x8, yk), ((f32x4){0.f, 0.f, 0.f, 0.f}));
                  u32x2 wv; wv.x = pk2(mt[0], mt[1]); wv.y = pk2(mt[2], mt[3]);
                  if (v2 < 2) *(u32x2*)(MTn + (16 * v2 + fr) * 520 + 16 * (4 * w + q) + 4 * fq) = wv;
                  else if (fr == 0) *(u32x2*)(nrn + 16 * (4 * w + q) + 4 * fq) = wv; } }
        }
        LBAR();
    }
    __syncthreads();
#undef ML_ISSUE
#undef LBAR
}
__device__ __forceinline__ void phase_ml_post(const Params& p) {
    bf16_t* up = (bf16_t*)(p.ws + A_PROJ); const bf16_t* xc = (const bf16_t*)(p.ws + A_XC);
    const int lane = TID() & 63, wg = BID() * 8 + (TID() >> 6), nw = GDIM() * 8;
    for (int t = wg; t < T_TOK; t += nw) {
        u32x4 hr[4], zr[4], xr[4];
#pragma unroll
        for (int hh = 0; hh < 4; ++hh) { const int ch = hh * 512 + lane * 8; hr[hh] = *(const u32x4*)(up + (size_t)t * 4096 + ch); zr[hh] = *(const u32x4*)(up + (size_t)t * 4096 + 2048 + ch); xr[hh] = *(const u32x4*)(xc + (size_t)t * 2048 + ch); }
#pragma unroll
        for (int hh = 0; hh < 4; ++hh) { const int ch = hh * 512 + lane * 8;
            float hv[8], zv[8], xv[8], y[8]; UNPACK8(hr[hh], hv); UNPACK8(zr[hh], zv); UNPACK8(xr[hh], xv);
            float s = 0.f;
#pragma unroll
            for (int e = 0; e < 8; ++e) s += hv[e];
#pragma unroll
            for (int o = 32; o >= 1; o >>= 1) s += __shfl_xor(s, o);
            const float mu = s * (1.0f / 512.0f); float q = 0.f;
#pragma unroll
            for (int e = 0; e < 8; ++e) { hv[e] -= mu; q += hv[e] * hv[e]; }
#pragma unroll
            for (int o = 32; o >= 1; o >>= 1) q += __shfl_xor(q, o);
            const float rstd = rsqrtf(q * (1.0f / 512.0f) + 1e-6f);
            const f32x4 g0 = *(const f32x4*)(p.in[31] + ch), g1 = *(const f32x4*)(p.in[31] + ch + 4), k0 = *(const f32x4*)(p.in[32] + ch), k1 = *(const f32x4*)(p.in[32] + ch + 4);
#pragma unroll
            for (int e = 0; e < 4; ++e) { y[e] = (hv[e] * rstd * g0[e] + k0[e] * xv[e]) * siluf(zv[e]); y[4 + e] = (hv[4 + e] * rstd * g1[e] + k1[e] * xv[4 + e]) * siluf(zv[4 + e]); }
            *(u32x4*)(up + (size_t)t * 4096 + 2048 + ch) = PACK8(y); }
    }
}
typedef const __attribute__((address_space(4))) Params* CPar;
#if defined(__HIP_DEVICE_COMPILE__)
__device__ __forceinline__ Params ldp() { CPar q = (CPar)__builtin_amdgcn_kernarg_segment_ptr(); asm volatile("" : "+s"(q)); Params r; for (int i = 0; i < 35; ++i) r.in[i] = q->in[i]; r.out = q->out; r.ws = q->ws; return r; }
#else
__device__ __forceinline__ Params ldp() { return Params{}; }
#endif
__global__ void __launch_bounds__(512) fwd_megakernel(Params p_unused) {
    extern __shared__ __attribute__((aligned(16))) unsigned char shm[];
    cg::grid_group grid = cg::this_grid();
    LAS unsigned char* lds = (LAS unsigned char*)shm;
    unsigned char* sm = shm;
#define GSYNC() do { XcdBarrier b_; b_.bar = (unsigned*)(ldp().ws + S_BAR); b_.x = xb_xcc_id(); b_.st = (volatile LAS unsigned*)(lds + 163776); xcd_barrier(b_); } while (0)
    if (threadIdx.x < 4) ((volatile LAS unsigned*)(lds + 163776))[threadIdx.x] = 0u;
    if (blockIdx.x == 0) { unsigned* bw = (unsigned*)(ldp().ws + S_BAR); for (int i = threadIdx.x; i < XCD_BAR_WORDS; i += 512) bw[i] = 0u; }
    grid.sync();
    xcd_barrier_post((unsigned*)(ldp().ws + S_BAR));
    { const Params p = ldp(); phase_prologue(p, sm); }
    GSYNC();
#pragma unroll 1
    for (int fi = 0; fi < 4; ++fi) {
        const int l = fi >> 1, f = fi & 1, sub = f ? 2 : 0;
        { const Params p = ldp(); const float* modl = (const float*)(p.ws + S_MOD) + (size_t)l * 4 * 9216;
          if (fi == 0) phase_norm(p.in[0], (bf16_t*)(p.ws + A_H), p.in[4] + (l * 3 + sub) * 1024, modl + sub * 3072);
          else phase_norm_b((const bf16_t*)p.out + XB_OFF, (bf16_t*)(p.ws + A_H), p.in[4] + (l * 3 + sub) * 1024, modl + sub * 3072); }
        if (fi == 2) { const Params p = ldp(); phase_cvt_l1(p, sm); }
        GSYNC();
        { const Params p = ldp(); pg8::Gemm g{(const bf16_t*)(p.ws + A_H), (const bf16_t*)(p.ws + (f ? W_GU1 : W_GU0)), T_TOK, 5632, 1024, 1024, 0}; EpiSwiglu e{(bf16_t*)(p.ws + A_PROJ)}; pg8::gemm_phase(lds, g, e); }
        GSYNC();
        { const Params p = ldp(); const float* modl = (const float*)(p.ws + S_MOD) + (size_t)l * 4 * 9216;
          pg8::Gemm g{(const bf16_t*)(p.ws + A_PROJ), (const bf16_t*)(p.ws + (f ? W_DN1 : W_DN0)), T_TOK, 1024, 2816, ACT_LD, 0};
          bf16_t* xb = (bf16_t*)p.out + XB_OFF;
          if (fi == 0) { EpiResidT<true> e{p.in[0], xb, modl + sub * 3072 + 2048, 0.5f}; pg8::gemm_phase(lds, g, e); }
          else { EpiResidT<false> e{xb, xb, modl + sub * 3072 + 2048, 0.5f}; pg8::gemm_phase(lds, g, e); } }
        GSYNC();
        if (f == 0) {
            { const Params p = ldp(); const float* modl = (const float*)(p.ws + S_MOD) + (size_t)l * 4 * 9216;
              phase_norm_b((const bf16_t*)p.out + XB_OFF, (bf16_t*)(p.ws + A_H), p.in[4] + (l * 3 + 1) * 1024, modl + 3072); }
            GSYNC();
            { const Params p = ldp(); pg8::Gemm g{(const bf16_t*)(p.ws + A_H), (const bf16_t*)(p.ws + W_X0), T_TOK, l == 0 ? 4864 : 4096, 1024, 1024, 0};
              EpiProj e{(bf16_t*)(p.ws + A_PROJ), l == 0 ? PROJ_LD : 4096, l == 0 ? 18 : -1, (float*)(p.ws + A_DT)}; pg8::gemm_phase(lds, g, e); }
            GSYNC();
            if (l == 0) {
                { const Params p = ldp(); for (int u = BID(); u < 512; u += GDIM()) ssd_pass1_unit(p, u, sm); }
                GSYNC();
                { const Params p = ldp(); phase_ssd_rec(p); }
                { const Params p = ldp(); phase_lru_conv(p); }
                GSYNC();
                { const Params p = ldp(); for (int u = BID(); u < 512; u += GDIM()) ssd_pass3_unit(p, u, sm); }
                GSYNC();
                { const Params p = ldp(); pg8::Gemm g{(const bf16_t*)(p.ws + A_H), (const bf16_t*)(p.ws + W_LRU), T_TOK, 2048, 256, 1024, 256};
                  EpiLru e{(bf16_t*)(p.ws + A_PROJ), (const bf16_t*)(p.ws + A_H), p.in[13], p.in[15], p.in[16]}; pg8::gemm_phase(lds, g, e); }
                GSYNC();
                { const Params p = ldp(); phase_lru_agg(p); }
                GSYNC();
                { const Params p = ldp(); phase_lru_final(p); }
                GSYNC();
            } else {
                { const Params p = ldp(); phase_ml_conv(p); }
                GSYNC();
                { const Params p = ldp(); phase_ml_intra(p, sm); }
                GSYNC();
                { const Params p = ldp(); for (int it = BID(); it < 256; it += GDIM()) ml_seq_item(p, it, sm, lds); }
                GSYNC();
                { const Params p = ldp(); phase_ml_post(p); }
                GSYNC();
            }
            { const Params p = ldp(); const float* modl = (const float*)(p.ws + S_MOD) + (size_t)l * 4 * 9216;
              pg8::Gemm go = (l == 0) ? pg8::Gemm{(const bf16_t*)(p.ws + A_PROJ), (const bf16_t*)(p.ws + W_HOUT), T_TOK, 1024, 2048, PROJ_LD, 0}
                                      : pg8::Gemm{(const bf16_t*)(p.ws + A_PROJ) + 2048, (const bf16_t*)(p.ws + W_MLDN), T_TOK, 1024, 2048, 4096, 0};
              bf16_t* xb = (bf16_t*)p.out + XB_OFF; EpiResidT<false> e{xb, xb, modl + 3072 + 2048, 1.0f}; pg8::gemm_phase(lds, go, e); }
            GSYNC();
        }
    }
    { const Params p = ldp(); phase_final_norm_b((const bf16_t*)p.out + XB_OFF, p.out, nullptr, p.in[34]); }
}

extern "C" void kernel_launch(void* const* d_in, const int* in_sizes, int n_in, void* d_out, int out_size, void* d_ws, size_t ws_size, hipStream_t stream) {
    static int grid_blocks = 0;
    const size_t ldsb = 163840;
    if (!grid_blocks) {
        (void)hipFuncSetAttribute((const void*)fwd_megakernel, hipFuncAttributeMaxDynamicSharedMemorySize, (int)ldsb);
        int dev = 0, cus = 0, per = 0; (void)hipGetDevice(&dev);
        (void)hipDeviceGetAttribute(&cus, hipDeviceAttributeMultiprocessorCount, dev);
        (void)hipOccupancyMaxActiveBlocksPerMultiprocessor(&per, fwd_megakernel, 512, ldsb);
        if (per < 1) per = 1;
        grid_blocks = cus * per;
    }
    Params p{};
    for (int i = 0; i < 35; ++i) p.in[i] = (const float*)d_in[i];
    p.out = (float*)d_out; p.ws = (unsigned char*)d_ws;
    void* args[] = {&p};
    hipError_t e = hipLaunchCooperativeKernel((void*)fwd_megakernel, dim3(grid_blocks), dim3(512), args, ldsb, stream);
    if (e != hipSuccess) fprintf(stderr, "cooperative launch failed: %s (grid %d)\n", hipGetErrorString(e), grid_blocks);
}
```
